# Optimizing an MI355X kernel written in HIP

```python
import jax
import jax.numpy as jnp
from jax import lax
import numpy as np

D_MODEL = 1024
BATCH = 16
SEQ = 2048
DEPTH = 2

GRID_W = 64
CTX_LEN = 256
EPS = 1e-6

M_HEADS = 4
M_HEAD_DIM = 128
M_WIDTH = M_HEADS * M_HEAD_DIM
M_CHUNK = 128
QK_CONV = 3
M_FORGET_BIAS = 3.0
A_HEADS = 4
Q_LORA = 384
KV_LORA = 256
NOPE_DIM = 128
ROPE_DIM = 64
V_DIM = 128
A_WIDTH = A_HEADS * V_DIM
Q_BLOCK = 128
ROPE_BASE = 10000.0
G_GROUPS = 4
G_CH = 128
G_WIDTH = G_GROUPS * G_CH
G_CHUNK = 128
N_BRANCH = 3
BRANCH_WIDTH = 512
D_FF = 2816
FFN_CONV = 3

IN_SIZES = (M_WIDTH, M_WIDTH, M_WIDTH, M_WIDTH, 4 * M_HEADS, Q_LORA, KV_LORA, ROPE_DIM,
            G_WIDTH, G_WIDTH, N_BRANCH * D_MODEL)
IN_DIM = sum(IN_SIZES)
IN_SPLITS = tuple(sum(IN_SIZES[:i + 1]) for i in range(len(IN_SIZES) - 1))

kernel_name = 'hybrid_mlstm_mla_sgu_convffn_dit'


def rms_norm(x, g):
    xf = x.astype(jnp.float32)
    y = xf * lax.rsqrt(jnp.mean(xf * xf, axis=-1, keepdims=True) + EPS)
    return (y * g.astype(jnp.float32)).astype(x.dtype)


def dw_conv(x, w, b):
    k = w.shape[0]
    pad = k // 2
    n = x.shape[1]
    xp = jnp.pad(x, ((0, 0), (pad, pad), (0, 0)))
    out = b + xp[:, 0:n] * w[0]
    for j in range(1, k):
        out = out + xp[:, j:j + n] * w[j]
    return out


def axial_rope(n_tokens):
    rows = n_tokens // GRID_W
    row = jnp.repeat(jnp.arange(rows), GRID_W)
    col = jnp.tile(jnp.arange(GRID_W), rows)
    n_freq = ROPE_DIM // 4
    inv = ROPE_BASE ** (-jnp.arange(n_freq, dtype=jnp.float32) / n_freq)
    ang = jnp.concatenate([row[:, None] * inv, col[:, None] * inv], axis=-1)
    return jnp.cos(ang), jnp.sin(ang)


def apply_rope(x, cos, sin):
    shape = (cos.shape[0],) + (1,) * (x.ndim - 3) + (cos.shape[-1],)
    cos = cos.reshape(shape).astype(x.dtype)
    sin = sin.reshape(shape).astype(x.dtype)
    x1, x2 = x[..., 0::2], x[..., 1::2]
    return jnp.stack([x1 * cos - x2 * sin, x1 * sin + x2 * cos], axis=-1).reshape(x.shape)


def mlstm_zero_state(batch):
    return (jnp.zeros((batch, M_HEADS, M_HEAD_DIM, M_HEAD_DIM), jnp.float32),
            jnp.zeros((batch, M_HEADS, M_HEAD_DIM), jnp.float32),
            jnp.zeros((batch, M_HEADS), jnp.float32))


def mlstm_prepare(q, k, v, gate_pre, w_conv, b_conv, b_gate):
    B, L, _ = q.shape
    qk = jax.nn.silu(dw_conv(jnp.concatenate([q, k], axis=-1), w_conv, b_conv))
    q, k = jnp.split(qk, 2, axis=-1)
    heads = lambda a: a.reshape(B, L, M_HEADS, M_HEAD_DIM).transpose(0, 2, 1, 3).astype(jnp.float32)
    q, k, v = heads(q), heads(k) * (M_HEAD_DIM ** -0.5), heads(v)
    g = (gate_pre + b_gate).astype(jnp.float32).reshape(B, L, 2, 2, M_HEADS).transpose(2, 3, 0, 4, 1)
    log_i = g[:, 0]
    log_f = jax.nn.log_sigmoid(g[:, 1])
    return q, k, v, log_i, log_f


def mlstm_chunked(q, k, v, log_i, log_f, state):
    B, H, L, d = q.shape
    nc = L // M_CHUNK
    to_chunks = lambda a: jnp.moveaxis(a.reshape(B, H, nc, M_CHUNK, *a.shape[3:]), 2, 0)
    xs = (to_chunks(q), to_chunks(k), to_chunks(v), to_chunks(log_i), to_chunks(log_f))
    lower = jnp.tril(jnp.ones((M_CHUNK, M_CHUNK), dtype=bool))

    def step(carry, inp):
        C, n, m = carry
        qc, kc, vc, ic, fc = inp
        b = jnp.cumsum(fc, axis=-1)
        dmat = jnp.where(lower, b[..., :, None] - b[..., None, :] + ic[..., None, :], -jnp.inf)
        inter = b + m[..., None]
        m_t = jnp.maximum(inter, jnp.max(dmat, axis=-1))
        w_intra = jnp.exp(dmat - m_t[..., None])
        w_inter = jnp.exp(inter - m_t)
        s = jnp.einsum('bhtd,bhsd->bhts', qc, kc) * w_intra
        num = w_inter[..., None] * jnp.einsum('bhtd,bhde->bhte', qc, C) + jnp.einsum('bhts,bhse->bhte', s, vc)
        den = w_inter * jnp.einsum('bhtd,bhd->bht', qc, n) + jnp.sum(s, axis=-1)
        h = num / jnp.maximum(jnp.abs(den), jnp.exp(-m_t))[..., None]
        b_last = b[..., -1]
        decay_s = b_last[..., None] - b + ic
        m_new = jnp.maximum(b_last + m, jnp.max(decay_s, axis=-1))
        ws = jnp.exp(decay_s - m_new[..., None])
        wc = jnp.exp(b_last + m - m_new)
        C_new = wc[..., None, None] * C + jnp.einsum('bhs,bhsd,bhse->bhde', ws, kc, vc)
        n_new = wc[..., None] * n + jnp.einsum('bhs,bhsd->bhd', ws, kc)
        return (C_new, n_new, m_new), h

    state, hs = lax.scan(step, state, xs)
    return jnp.moveaxis(hs, 0, 2).reshape(B, H, L, d), state


def mlstm_bidir(q, k, v, log_i, log_f, states):
    h_f, s_f = mlstm_chunked(q, k, v, log_i[0], log_f[0], states[0])
    flip = lambda a: jnp.flip(a, axis=2)
    h_b, s_b = mlstm_chunked(flip(q), flip(k), flip(v), flip(log_i[1]), flip(log_f[1]), states[1])
    return h_f + flip(h_b), (s_f, s_b)


def mlstm_output(h, o, g_head):
    B, H, L, d = h.shape
    h = rms_norm(h.transpose(0, 2, 1, 3), g_head.reshape(H, d)).reshape(B, L, H * d)
    return jax.nn.sigmoid(o) * h.astype(o.dtype)


def mla_q(cq, g_qn, w_uq, rope):
    B, L, _ = cq.shape
    q = (rms_norm(cq, g_qn) @ w_uq).reshape(B, L, A_HEADS, NOPE_DIM + ROPE_DIM)
    if rope is None:
        return q
    return jnp.concatenate([q[..., :NOPE_DIM], apply_rope(q[..., NOPE_DIM:], *rope)], axis=-1)


def mla_kv(ckv, k_rope, g_kvn, w_ukv, rope):
    B, L, _ = ckv.shape
    kv = (rms_norm(ckv, g_kvn) @ w_ukv).reshape(B, L, A_HEADS, NOPE_DIM + V_DIM)
    if rope is not None:
        k_rope = apply_rope(k_rope, *rope)
    k_rope = jnp.broadcast_to(k_rope[:, :, None, :], (B, L, A_HEADS, ROPE_DIM))
    k = jnp.concatenate([kv[..., :NOPE_DIM], k_rope], axis=-1)
    return k, kv[..., NOPE_DIM:]


def attend_blocked(q, k, v):
    B, Lq, H, dk = q.shape
    nb = Lq // Q_BLOCK
    qb = jnp.moveaxis(q.reshape(B, nb, Q_BLOCK, H, dk), 1, 0)
    scale = dk ** -0.5

    def one(q_blk):
        s = jnp.einsum('bqhd,bkhd->bhqk', q_blk, k, preferred_element_type=jnp.float32) * scale
        p = jax.nn.softmax(s, axis=-1).astype(v.dtype)
        return jnp.einsum('bhqk,bkhd->bqhd', p, v)

    o = lax.map(one, qb)
    return jnp.moveaxis(o, 0, 1).reshape(B, Lq, H * v.shape[-1])


def spatial_gating(u, v, g_norm, w_s, b_s):
    B, L, _ = u.shape
    nc = L // G_CHUNK
    u = jax.nn.gelu(u)
    v = jax.nn.gelu(v).reshape(B, nc, G_CHUNK, G_GROUPS, G_CH)
    v = rms_norm(v, g_norm.reshape(G_GROUPS, G_CH))
    mixed = jnp.einsum('gts,bnsgc->bntgc', w_s, v) + b_s.T[:, :, None]
    return u * mixed.reshape(B, L, G_WIDTH)


def merge_branches(ya, yb, yc, gate_pre, w_branch, w_out):
    y = jnp.stack([ya, yb, yc], axis=-2)
    proj = jnp.einsum('blgc,gcd->blgd', y, w_branch)
    gates = jax.nn.sigmoid(gate_pre.reshape(*gate_pre.shape[:-1], N_BRANCH, D_MODEL))
    return jnp.sum(gates * proj, axis=-2) @ w_out


def conv_ffn(h, w_up, w_conv, b_conv, w_down):
    a = dw_conv(h @ w_up, w_conv, b_conv)
    gate, val = jnp.split(a, 2, axis=-1)
    return (jax.nn.silu(gate) * val) @ w_down


def hybrid_layer(x, ctx, cond_x, cond_c, rope, need_ctx_out,
                 w_ada, b_ada, g_mix, w_in, w_qkconv, b_qkconv, b_mgate, g_mhead,
                 g_qnorm, w_uq, g_kvnorm, w_ukv, g_sgu, w_s, b_s, w_branch, w_out,
                 g_ffn, w_up, w_ffconv, b_ffconv, w_down):
    batch = x.shape[0]
    mod_x = jnp.split((cond_x @ w_ada + b_ada)[:, None, :], 6, axis=-1)
    mod_c = jnp.split(cond_c @ w_ada + b_ada, 6, axis=-1)

    hx = rms_norm(x, g_mix) * (1.0 + mod_x[1]) + mod_x[0]
    hc = rms_norm(ctx, g_mix) * (1.0 + mod_c[1]) + mod_c[0]
    (qx, kx, vx, ox, mgx, cqx, ckvx, krx, ux, sx, gtx) = jnp.split(hx @ w_in, IN_SPLITS, axis=-1)
    (qc, kc, vc, oc, mgc, cqc, ckvc, krc, uc, sc, gtc) = jnp.split(hc @ w_in, IN_SPLITS, axis=-1)

    h_c, ctx_states = mlstm_bidir(*mlstm_prepare(qc, kc, vc, mgc, w_qkconv, b_qkconv, b_mgate),
                                  (mlstm_zero_state(batch), mlstm_zero_state(batch)))
    h_x, _ = mlstm_bidir(*mlstm_prepare(qx, kx, vx, mgx, w_qkconv, b_qkconv, b_mgate), ctx_states)
    ya_x = mlstm_output(h_x, ox, g_mhead)

    k_ctx, v_ctx = mla_kv(ckvc, krc, g_kvnorm, w_ukv, None)
    k_lat, v_lat = mla_kv(ckvx, krx, g_kvnorm, w_ukv, rope)
    yb_x = attend_blocked(mla_q(cqx, g_qnorm, w_uq, rope),
                          jnp.concatenate([k_lat, k_ctx], axis=1),
                          jnp.concatenate([v_lat, v_ctx], axis=1))

    yc_x = spatial_gating(ux, sx, g_sgu, w_s, b_s)

    x = x + mod_x[2] * merge_branches(ya_x, yb_x, yc_x, gtx, w_branch, w_out)
    hx2 = rms_norm(x, g_ffn) * (1.0 + mod_x[4]) + mod_x[3]
    x = x + mod_x[5] * conv_ffn(hx2, w_up, w_ffconv, b_ffconv, w_down)

    if need_ctx_out:
        ya_c = mlstm_output(h_c, oc, g_mhead)
        yb_c = attend_blocked(mla_q(cqc, g_qnorm, w_uq, None), k_ctx, v_ctx)
        yc_c = spatial_gating(uc, sc, g_sgu, w_s, b_s)
        ctx = ctx + mod_c[2] * merge_branches(ya_c, yb_c, yc_c, gtc, w_branch, w_out)
        hc2 = rms_norm(ctx, g_ffn) * (1.0 + mod_c[4]) + mod_c[3]
        ctx = ctx + mod_c[5] * conv_ffn(hc2, w_up, w_ffconv, b_ffconv, w_down)
    return x, ctx


def setup_inputs(seed: int = 0) -> dict:
    key = jax.random.key(seed)
    ks = iter(jax.random.split(key, 32))
    nrm = lambda shape, scale: jax.random.normal(next(ks), shape, jnp.float32) * scale
    gain = lambda shape: 1.0 + nrm(shape, 0.02)
    L = DEPTH
    forget_cols = ((jnp.arange(4 * M_HEADS) // M_HEADS) % 2 == 1).astype(jnp.float32)
    return {
        'x': nrm((BATCH, SEQ, D_MODEL), 1.0),
        'c': nrm((BATCH, D_MODEL), 1.0),
        'ctx': nrm((BATCH, CTX_LEN, D_MODEL), 1.0),
        'c_ctx': nrm((D_MODEL,), 1.0),
        'w_ada': nrm((L, D_MODEL, 6 * D_MODEL), 0.5 * D_MODEL ** -0.5),
        'b_ada': nrm((L, 6 * D_MODEL), 0.02),
        'g_mix': gain((L, D_MODEL)),
        'w_in': nrm((L, D_MODEL, IN_DIM), D_MODEL ** -0.5),
        'w_qkconv': nrm((L, QK_CONV, 2 * M_WIDTH), QK_CONV ** -0.5),
        'b_qkconv': nrm((L, 2 * M_WIDTH), 0.02),
        'b_mgate': nrm((L, 4 * M_HEADS), 0.1) + M_FORGET_BIAS * forget_cols,
        'g_mhead': gain((L, M_WIDTH)),
        'g_qnorm': gain((L, Q_LORA)),
        'w_uq': nrm((L, Q_LORA, A_HEADS * (NOPE_DIM + ROPE_DIM)), Q_LORA ** -0.5),
        'g_kvnorm': gain((L, KV_LORA)),
        'w_ukv': nrm((L, KV_LORA, A_HEADS * (NOPE_DIM + V_DIM)), KV_LORA ** -0.5),
        'g_sgu': gain((L, G_WIDTH)),
        'w_s': nrm((L, G_GROUPS, G_CHUNK, G_CHUNK), G_CHUNK ** -0.5),
        'b_s': gain((L, G_GROUPS, G_CHUNK)),
        'w_branch': nrm((L, N_BRANCH, BRANCH_WIDTH, D_MODEL), BRANCH_WIDTH ** -0.5),
        'w_out': nrm((L, D_MODEL, D_MODEL), D_MODEL ** -0.5),
        'g_ffn': gain((L, D_MODEL)),
        'w_up': nrm((L, D_MODEL, 2 * D_FF), D_MODEL ** -0.5),
        'w_ffconv': nrm((L, FFN_CONV, 2 * D_FF), FFN_CONV ** -0.5),
        'b_ffconv': nrm((L, 2 * D_FF), 0.02),
        'w_down': nrm((L, D_FF, D_MODEL), D_FF ** -0.5),
        'g_final': gain((D_MODEL,)),
    }


def reference(x, c, ctx, c_ctx, w_ada, b_ada, g_mix, w_in, w_qkconv, b_qkconv, b_mgate, g_mhead,
              g_qnorm, w_uq, g_kvnorm, w_ukv, g_sgu, w_s, b_s, w_branch, w_out,
              g_ffn, w_up, w_ffconv, b_ffconv, w_down, g_final):
    rope = axial_rope(x.shape[1])
    cond_x = jax.nn.silu(c)
    cond_c = jax.nn.silu(c_ctx)
    for l in range(DEPTH):
        x, ctx = hybrid_layer(x, ctx, cond_x, cond_c, rope, l < DEPTH - 1,
                              w_ada[l], b_ada[l], g_mix[l], w_in[l], w_qkconv[l], b_qkconv[l],
                              b_mgate[l], g_mhead[l], g_qnorm[l], w_uq[l], g_kvnorm[l], w_ukv[l],
                              g_sgu[l], w_s[l], b_s[l], w_branch[l], w_out[l],
                              g_ffn[l], w_up[l], w_ffconv[l], b_ffconv[l], w_down[l])
    return rms_norm(x, g_final)
```

```cpp
#include <hip/hip_runtime.h>
#include <hip/hip_cooperative_groups.h>
#include <cstdio>
namespace cg = cooperative_groups;

#define LAS __attribute__((address_space(3)))
#define GAS __attribute__((address_space(1)))
typedef unsigned short bf16_t;
typedef short bf16x8 __attribute__((ext_vector_type(8)));
typedef float f32x4 __attribute__((ext_vector_type(4)));
typedef float f32x2 __attribute__((ext_vector_type(2)));
typedef unsigned u32x4 __attribute__((ext_vector_type(4)));
typedef unsigned u32x2 __attribute__((ext_vector_type(2)));

constexpr int DM = 1024, NB = 16, SEQ = 2048, CTXL = 256, SEQT = 2304;
constexpr int NGRP = 2, GB = 8, T = GB * SEQT;
constexpr int NZ1 = 3840, NZG = 3072, NIN = 6912;
constexpr int ZQ = 0, ZK = 512, ZV = 1024, ZO = 1536, ZCQ = 2048, ZCKV = 2432, ZKR = 2688, ZMG = 2752, ZU = 2816, ZS = 3328;
constexpr int DFF = 2816;
constexpr int NTHREADS = 512;
constexpr int LDS_BYTES = 155648;
constexpr float EPS = 1e-6f;
constexpr float QSCALE = 0.07216878364870322f * 1.4426950408889634f;

constexpr size_t WS_WIN = 0;
constexpr size_t WS_WUQ = WS_WIN + (size_t)NIN * 1024 * 2;
constexpr size_t WS_WUKV = WS_WUQ + (size_t)768 * 384 * 2;
constexpr size_t WS_WBR = WS_WUKV + (size_t)1024 * 256 * 2;
constexpr size_t WS_WOUT = WS_WBR + (size_t)3 * 1024 * 512 * 2;
constexpr size_t WS_WUP = WS_WOUT + (size_t)1024 * 1024 * 2;
constexpr size_t WS_WDN = WS_WUP + (size_t)5632 * 1024 * 2;
constexpr size_t WS_MOD = WS_WDN + (size_t)1024 * 2816 * 2;
constexpr size_t WS_ROPE = WS_MOD + (size_t)2 * 17 * 6144 * 4;
constexpr size_t WS_CNT = WS_ROPE + (size_t)2048 * 32 * 2 * 4;
constexpr size_t WS_BAR = WS_CNT + 4096;
constexpr size_t WS_CTXS = WS_BAR + 16384;
constexpr size_t WS_RS = WS_CTXS + (size_t)4096 * 1024 * 4;
constexpr size_t WS_H = WS_RS + (size_t)T * 2 * 4;
constexpr size_t WS_Z1 = WS_H + (size_t)T * 1024 * 2;
constexpr size_t WS_ZG = WS_Z1 + (size_t)T * NZ1 * 2;
constexpr size_t WS_QA = WS_ZG + (size_t)T * NZG * 2;
constexpr size_t WS_KV = WS_QA + (size_t)T * 768 * 2;
constexpr size_t WS_KR = WS_KV + (size_t)T * 1024 * 2;
constexpr size_t WS_HF = WS_KR + (size_t)T * 64 * 2;
constexpr size_t WS_HB = WS_HF + (size_t)T * 512 * 2;
constexpr size_t WS_Y = WS_HB + (size_t)T * 512 * 2;
constexpr size_t WS_EDGE = WS_Y + (size_t)T * 1536 * 2;
constexpr size_t WS_END = WS_EDGE + (size_t)72 * 16 * 5632 * 2;
constexpr size_t WS_M32 = WS_Z1;
constexpr size_t WS_MB = WS_Z1 + (size_t)T * 1024 * 4;
constexpr size_t WS_AUP = WS_Z1;
constexpr size_t WS_HID = WS_QA;
static_assert((size_t)T * 2816 * 2 <= (WS_EDGE - WS_QA), "HID alias");
static_assert((size_t)T * 1024 * 6 <= (size_t)T * NZ1 * 2, "M alias");
static_assert(WS_END <= (size_t)512 * 1024 * 1024, "workspace");

struct Params { const float* in[27]; float* out; unsigned char* ws; };
#ifndef PROBE
#define PROBE 0
#endif
#define REP(bit) for (int rep_ = 0; rep_ < (((PROBE) >> (bit)) & 1) + 1; ++rep_)

__device__ __forceinline__ unsigned pk2(float lo, float hi) { unsigned r; asm volatile("v_cvt_pk_bf16_f32 %0, %1, %2" : "=v"(r) : "v"(lo), "v"(hi)); return r; }
__device__ __forceinline__ float bflo(unsigned w) { return __uint_as_float(w << 16); }
__device__ __forceinline__ float bfhi(unsigned w) { return __uint_as_float(w & 0xffff0000u); }
__device__ __forceinline__ float bf2f(bf16_t h) { return __uint_as_float(((unsigned)h) << 16); }
__device__ __forceinline__ bf16_t f2bf(float f) { return (bf16_t)(pk2(f, 0.f) & 0xffffu); }
__device__ __forceinline__ float shx(float v, int o, int lane) { return __int_as_float(__builtin_amdgcn_ds_bpermute((lane ^ o) << 2, __float_as_int(v))); }
__device__ __forceinline__ float shi(float v, int src) { return __int_as_float(__builtin_amdgcn_ds_bpermute(src << 2, __float_as_int(v))); }
__device__ __forceinline__ float wave_sum(float v, int lane) {
    (void)lane;
    v += __int_as_float(__builtin_amdgcn_update_dpp(0, __float_as_int(v), 0xB1, 0xf, 0xf, false));
    v += __int_as_float(__builtin_amdgcn_update_dpp(0, __float_as_int(v), 0x4E, 0xf, 0xf, false));
    v += __int_as_float(__builtin_amdgcn_update_dpp(0, __float_as_int(v), 0x141, 0xf, 0xf, false));
    v += __int_as_float(__builtin_amdgcn_update_dpp(0, __float_as_int(v), 0x140, 0xf, 0xf, false));
    const float s0 = __int_as_float(__builtin_amdgcn_readlane(__float_as_int(v), 0)), s1 = __int_as_float(__builtin_amdgcn_readlane(__float_as_int(v), 16));
    const float s2 = __int_as_float(__builtin_amdgcn_readlane(__float_as_int(v), 32)), s3 = __int_as_float(__builtin_amdgcn_readlane(__float_as_int(v), 48));
    return (s0 + s1) + (s2 + s3);
}
__device__ __forceinline__ float sigmoidf_(float x) { return 1.0f / (1.0f + __expf(-x)); }
__device__ __forceinline__ float siluf_(float x) { return x / (1.0f + __expf(-x)); }
__device__ __forceinline__ float geluf_(float x) {
    const float y2 = -1.5957691216057308f * (x + 0.044715f * x * x * x);
    return x * __builtin_amdgcn_rcpf(1.0f + __expf(y2));
}
__device__ __forceinline__ float logsigmoidf_(float x) { return fminf(x, 0.f) - log1pf(__expf(-fabsf(x))); }
__device__ __forceinline__ f32x4 mfma16(bf16x8 a, bf16x8 b, f32x4 c) { return __builtin_amdgcn_mfma_f32_16x16x32_bf16(a, b, c, 0, 0, 0); }

namespace pg8 {
constexpr int BM = 256, BK = 64, HALF = 128, HTB = HALF * BK * 2, STAGE_BYTES = 8 * HTB, NXCD = 8, WGM = 8;
__device__ __forceinline__ int lds_byte(int r, int c) { const int st = (r >> 4) * 2 + (c >> 5), rr = r & 15, cc = c & 31, ob = rr * 64 + cc * 2; return st * 1024 + (ob ^ (((ob >> 9) & 1) << 5)); }
__device__ __forceinline__ void stage_rc(int b, int& R, int& C) { const int st = b / 1024, sb = b % 1024, swz = sb ^ (((sb >> 9) & 1) << 5); R = (st >> 1) * 16 + swz / 64; C = (st & 1) * 32 + (swz % 64) / 2; }
__device__ __forceinline__ int perm32(int rho) { const int n = rho >> 4, i = rho & 15; return 8 * (i >> 2) + 4 * n + (i & 3); }
struct Unit { int pm, pn; };
struct Gemm { const bf16_t* A; const bf16_t* Bt; int lda, N, K, ldb; };
struct Order {
    int nM, nN, nwg, G, c, skipctx;
    __device__ void init(int nM_, int N, int G_, int c_, int skip) { nM = nM_; nN = N / BM; nwg = nM * nN; G = G_; c = c_; skipctx = skip; }
    __device__ bool next(int i, Unit& u) const {
        const long L = (long)i * G + c; if (L >= nwg) return false;
        int wgid = (int)L; { const int q = nwg / NXCD, r = nwg % NXCD, xcd = wgid % NXCD, off = wgid / NXCD; wgid = (xcd < r ? xcd * (q + 1) : r * (q + 1) + (xcd - r) * q) + off; }
        const int nig = WGM * nN, gid = wgid / nig, fm = gid * WGM, gsz = (nM - fm) < WGM ? (nM - fm) : WGM;
        u.pm = fm + ((wgid % nig) % gsz); u.pn = (wgid % nig) / gsz;
        if (skipctx) u.pm = (u.pm >> 3) * 9 + 1 + (u.pm & 7);
        return true;
    }
};

struct OneUnit {
    int pm, pn, valid;
    __device__ bool next(int i, Unit& u) const { if (i != 0 || !valid) return false; u.pm = pm; u.pn = pn; return true; }
};

struct OrderL1In {
    Order base;
    __device__ bool next(int i, Unit& u) const {
        const long L = (long)i * base.G + base.c;
        if (L < base.nwg) return base.next(i, u);
        const int j = (int)(L - base.nwg); if (j >= 64) return false;
        const int q = j & 7; u.pm = (j >> 3) * 9; u.pn = q < 6 ? q : q + 3; return true;
    }
};

template <class Epi, class Ord>
__device__ __forceinline__ void gemm_phase(LAS unsigned char* lds, const Gemm g, const Ord& S, const Epi& E, int tid_in) {
    int tid = tid_in; asm volatile("" : "+v"(tid));
    const int wid = __builtin_amdgcn_readfirstlane(tid >> 6), lane = tid & 63, wr = wid >> 2, wc = wid & 3, fr = lane & 15, fq = lane >> 4;
    const int K = g.K, nt = K / BK;
    unsigned voffA[2], voffB[2];
#pragma unroll
    for (int i = 0; i < 2; ++i) { int R, C; stage_rc(tid * 16 + i * 8192, R, C); const int Rb = Epi::PERM ? ((R & ~31) + perm32(R & 31)) : R;
        voffA[i] = (unsigned)(R * g.lda + C) * 2u; voffB[i] = (unsigned)(Rb * g.ldb + C) * 2u; }
    const size_t kstep = (size_t)(BK * 2);
    const size_t hstepA = (size_t)HALF * g.lda * 2, hstepB = (size_t)HALF * g.ldb * 2;
    const size_t tstepA = 2 * hstepA, tstepB = 2 * hstepB;
    const unsigned ldsw = (unsigned)wid * 1024u;
    const int aoff = lds_byte(wr * 64 + fr, fq * 8), boff = lds_byte(wc * 32 + fr, fq * 8);
#define PG8_SA(b, h) (((b) * 2 + (h)) * HTB)
#define PG8_SB(b, h) ((4 + (b) * 2 + (h)) * HTB)
#define PG8_STAGE(bufoff, gbase, voff) do { _Pragma("unroll") for (int _i = 0; _i < 2; ++_i) \
        __builtin_amdgcn_global_load_lds((const GAS unsigned*)((const char*)(gbase) + (voff)[_i]), (LAS unsigned*)(lds + (bufoff) + ldsw + _i * 8192), 16, 0, 0); } while (0)
#define PG8_LDA(dst, b, h) do { _Pragma("unroll") for (int m = 0; m < 4; ++m) _Pragma("unroll") for (int k = 0; k < 2; ++k) dst[m][k] = *(const LAS bf16x8*)(lds + PG8_SA(b, h) + aoff + m * 2048 + k * 1024); } while (0)
#define PG8_LDB(dst, b, h) do { _Pragma("unroll") for (int n = 0; n < 2; ++n) _Pragma("unroll") for (int k = 0; k < 2; ++k) dst[n][k] = *(const LAS bf16x8*)(lds + PG8_SB(b, h) + boff + n * 2048 + k * 1024); } while (0)
#define PG8_MMA(ai, bj, At, Bt) do { __builtin_amdgcn_s_setprio(1); _Pragma("unroll") for (int m = 0; m < 4; ++m) _Pragma("unroll") for (int n = 0; n < 2; ++n) _Pragma("unroll") for (int k = 0; k < 2; ++k) \
        acc[ai][bj][m][n] = __builtin_amdgcn_mfma_f32_16x16x32_bf16(Bt[n][k], At[m][k], acc[ai][bj][m][n], 0, 0, 0); __builtin_amdgcn_s_setprio(0); } while (0)
#define PG8_WAIT_V(n) asm volatile("s_waitcnt vmcnt(" #n ")" ::: "memory")
#define PG8_WAIT_L(n) asm volatile("s_waitcnt lgkmcnt(" #n ")" ::: "memory")
#define PG8_BAR __builtin_amdgcn_s_barrier()
#define PG8_SCHED __builtin_amdgcn_sched_barrier(0)
    Unit cur, nxt; int ui = 0;
    if (!S.next(0, cur)) return;
    f32x4 acc[2][2][4][2];
#pragma unroll
    for (int a = 0; a < 2; ++a)
#pragma unroll
        for (int b = 0; b < 2; ++b)
#pragma unroll
            for (int m = 0; m < 4; ++m)
#pragma unroll
                for (int n = 0; n < 2; ++n) acc[a][b][m][n] = (f32x4){0.f, 0.f, 0.f, 0.f};
    bf16x8 At[4][2], B0[2][2], B1[2][2];
    const char* cA = (const char*)g.A + (size_t)cur.pm * tstepA; const char* cB = (const char*)g.Bt + (size_t)cur.pn * tstepB;
    PG8_STAGE(PG8_SB(0, 0), cB, voffB); PG8_STAGE(PG8_SA(0, 0), cA, voffA); PG8_STAGE(PG8_SB(0, 1), cB + hstepB, voffB); PG8_STAGE(PG8_SA(0, 1), cA + hstepA, voffA);
    if (wr == 1) PG8_BAR;
    PG8_WAIT_V(4); PG8_BAR;
    PG8_STAGE(PG8_SB(1, 0), cB + kstep, voffB); PG8_STAGE(PG8_SA(1, 0), cA + kstep, voffA); PG8_STAGE(PG8_SB(1, 1), cB + hstepB + kstep, voffB);
    PG8_WAIT_V(6); PG8_BAR;
    for (;;) {
        const bool has_next = S.next(ui + 1, nxt);
        const char* nA = has_next ? (const char*)g.A + (size_t)nxt.pm * tstepA : cA; const char* nB = has_next ? (const char*)g.Bt + (size_t)nxt.pn * tstepB : cB;
        for (int t = 0; t < nt; t += 2) {
            const bool last = (t == nt - 2);
            const char* a1 = cA + (size_t)(t + 1) * kstep;
            const char* a2 = last ? nA : cA + (size_t)(t + 2) * kstep; const char* b2 = last ? nB : cB + (size_t)(t + 2) * kstep;
            const char* a3 = a2 + kstep; const char* b3 = b2 + kstep;
            if constexpr (Epi::RESCALE) { if (t == 8 || t == 16) { int ln_; asm volatile("v_mbcnt_lo_u32_b32 %0, -1, 0\n\tv_mbcnt_hi_u32_b32 %0, -1, %0" : "=v"(ln_)); E.rescale(acc, cur, t >> 4, wr, wc, ln_ & 15, ln_ >> 4); } }
            PG8_LDB(B0, 0, 0); PG8_SCHED; PG8_LDA(At, 0, 0); PG8_STAGE(PG8_SA(1, 1), a1 + hstepA, voffA);
            PG8_WAIT_L(8); PG8_BAR; PG8_WAIT_L(0); PG8_MMA(0, 0, At, B0); PG8_BAR; PG8_SCHED;
            PG8_LDB(B1, 0, 1); PG8_STAGE(PG8_SB(0, 0), b2, voffB);
            PG8_BAR; PG8_WAIT_L(0); PG8_MMA(0, 1, At, B1); PG8_BAR;
            PG8_LDA(At, 0, 1); PG8_STAGE(PG8_SA(0, 0), a2, voffA);
            PG8_BAR; PG8_WAIT_L(0); PG8_MMA(1, 0, At, B0); PG8_BAR; PG8_SCHED;
            PG8_STAGE(PG8_SB(0, 1), b2 + hstepB, voffB);
            PG8_WAIT_V(6); PG8_BAR; PG8_MMA(1, 1, At, B1); PG8_BAR;
            PG8_LDB(B0, 1, 0); PG8_SCHED; PG8_LDA(At, 1, 0); PG8_STAGE(PG8_SA(0, 1), a2 + hstepA, voffA);
            PG8_WAIT_L(8); PG8_BAR; PG8_WAIT_L(0); PG8_MMA(0, 0, At, B0); PG8_BAR; PG8_SCHED;
            PG8_LDB(B1, 1, 1); PG8_STAGE(PG8_SB(1, 0), b3, voffB);
            PG8_BAR; PG8_WAIT_L(0); PG8_MMA(0, 1, At, B1); PG8_BAR;
            PG8_LDA(At, 1, 1); PG8_STAGE(PG8_SA(1, 0), a3, voffA);
            PG8_BAR; PG8_WAIT_L(0); PG8_MMA(1, 0, At, B0); PG8_BAR; PG8_SCHED;
            PG8_STAGE(PG8_SB(1, 1), b3 + hstepB, voffB);
            PG8_WAIT_V(6); PG8_BAR; PG8_MMA(1, 1, At, B1); PG8_BAR;
        }
        { int ln_; asm volatile("v_mbcnt_lo_u32_b32 %0, -1, 0\n\tv_mbcnt_hi_u32_b32 %0, -1, %0" : "=v"(ln_)); E(acc, cur, wr, wc, ln_ & 15, ln_ >> 4); }
        if (!has_next) break;
#pragma unroll
        for (int a = 0; a < 2; ++a)
#pragma unroll
            for (int b = 0; b < 2; ++b)
#pragma unroll
                for (int m = 0; m < 4; ++m)
#pragma unroll
                    for (int n = 0; n < 2; ++n) acc[a][b][m][n] = (f32x4){0.f, 0.f, 0.f, 0.f};
        cur = nxt; cA = nA; cB = nB; ++ui;
    }
    PG8_WAIT_V(0);
    if (wr == 0) PG8_BAR;
    PG8_BAR;
#undef PG8_SA
#undef PG8_SB
#undef PG8_STAGE
#undef PG8_LDA
#undef PG8_LDB
#undef PG8_MMA
#undef PG8_WAIT_V
#undef PG8_WAIT_L
#undef PG8_BAR
#undef PG8_SCHED
}
}

typedef const f32x4 (&AccRef)[2][2][4][2];

struct EpiIn {
    static constexpr bool PERM = true, RESCALE = false;
    bf16_t* Z1; bf16_t* ZG;
    __device__ __forceinline__ void operator()(AccRef acc, const pg8::Unit& u, int wr, int wc, int fr, int fq) const {
        asm volatile("" : "+v"(fr), "+v"(fq));
        bf16_t* base; int ld;
        if (u.pn < 15) { base = Z1 + u.pn * 256; ld = NZ1; } else { base = ZG + (u.pn - 15) * 256; ld = NZG; }
        const int row0 = u.pm * 256 + wr * 64 + fr, col0 = wc * 32 + 8 * fq;
#pragma unroll
        for (int ai = 0; ai < 2; ++ai)
#pragma unroll
            for (int m = 0; m < 4; ++m) { bf16_t* rowp = base + (size_t)(row0 + ai * 128 + m * 16) * ld + col0;
#pragma unroll
                for (int bj = 0; bj < 2; ++bj) { const f32x4 v0 = acc[ai][bj][m][0], v1 = acc[ai][bj][m][1];
                    u32x4 w; w.x = pk2(v0[0], v0[1]); w.y = pk2(v0[2], v0[3]); w.z = pk2(v1[0], v1[1]); w.w = pk2(v1[2], v1[3]);
                    *(GAS u32x4*)(rowp + bj * 128) = w; } }
    }
};
struct EpiBf {
    static constexpr bool PERM = true, RESCALE = false;
    bf16_t* O; int ld; const float* rs;
    __device__ __forceinline__ void operator()(AccRef acc, const pg8::Unit& u, int wr, int wc, int fr, int fq) const {
        asm volatile("" : "+v"(fr), "+v"(fq));
        const int row0 = u.pm * 256 + wr * 64 + fr, col0 = u.pn * 256 + wc * 32 + 8 * fq;
#pragma unroll
        for (int ai = 0; ai < 2; ++ai)
#pragma unroll
            for (int m = 0; m < 4; ++m) { const int row = row0 + ai * 128 + m * 16; bf16_t* rowp = O + (size_t)row * ld + col0;
                const float s = rs ? ((const GAS float*)rs)[row * 2] : 1.0f;
#pragma unroll
                for (int bj = 0; bj < 2; ++bj) { const f32x4 v0 = acc[ai][bj][m][0] * s, v1 = acc[ai][bj][m][1] * s;
                    u32x4 w; w.x = pk2(v0[0], v0[1]); w.y = pk2(v0[2], v0[3]); w.z = pk2(v1[0], v1[1]); w.w = pk2(v1[2], v1[3]);
                    *(GAS u32x4*)(rowp + bj * 128) = w; } }
    }
};
struct EpiVT {
    static constexpr bool PERM = true, RESCALE = false;
    bf16_t* O; const float* rs;
    __device__ __forceinline__ void operator()(AccRef acc, const pg8::Unit& u, int wr, int wc, int fr, int fq) const {
        asm volatile("" : "+v"(fr), "+v"(fq));
        const int bl = u.pn / 9, p0 = (u.pn % 9) * 256;
        const int f0 = u.pm * 256 + wr * 64 + fr;
#pragma unroll
        for (int bj = 0; bj < 2; ++bj)
#pragma unroll
            for (int n = 0; n < 2; ++n) { const int cl = bj * 128 + wc * 32 + 8 * fq + 4 * n;
                const GAS float* rp = (const GAS float*)(rs + (size_t)(u.pn * 256 + cl) * 2);
                const float s0 = rp[0], s1 = rp[2], s2 = rp[4], s3 = rp[6];
                const int pos = (cl & ~31) + ((cl >> 2) & 3) * 8 + ((cl >> 4) & 1) * 4;
#pragma unroll
                for (int ai = 0; ai < 2; ++ai)
#pragma unroll
                    for (int m = 0; m < 4; ++m) { const int f = f0 + ai * 128 + m * 16; const int hh = f >> 7, e = f & 127;
                        const f32x4 v = acc[ai][bj][m][n];
                        u32x2 w; w.x = pk2(v[0] * s0, v[1] * s1); w.y = pk2(v[2] * s2, v[3] * s3);
                        *(GAS u32x2*)(O + ((size_t)((bl * 4 + hh) * 128 + e)) * SEQT + p0 + pos) = w; }
                asm volatile("" ::: "memory"); }
    }
};
struct EpiQ {
    static constexpr bool PERM = false, RESCALE = false;
    bf16_t* O; const float* rs; const float* rope;
    __device__ __forceinline__ void operator()(AccRef acc, const pg8::Unit& u, int wr, int wc, int fr, int fq) const {
        asm volatile("" : "+v"(fr), "+v"(fq));
        const int row0 = u.pm * 256 + wr * 64 + fr;
        const bool lat = (u.pm % 9) != 0;
        const int posb = ((u.pm % 9) - 1) * 256 + wr * 64 + fr;
#pragma unroll
        for (int ai = 0; ai < 2; ++ai)
#pragma unroll
            for (int m = 0; m < 4; ++m) { const int row = row0 + ai * 128 + m * 16; const int pos = posb + ai * 128 + m * 16;
                const float s = ((const GAS float*)rs)[row * 2] * QSCALE;
#pragma unroll
                for (int bj = 0; bj < 2; ++bj)
#pragma unroll
                    for (int n = 0; n < 2; ++n) { const int c0 = u.pn * 256 + bj * 128 + wc * 32 + 16 * n + 4 * fq; const int within = c0 % 192;
                        f32x4 v0 = acc[ai][bj][m][n] * s;
                        if (lat && within >= 128) { const int i0 = (within - 128) >> 1; const f32x4 r0 = *(const GAS f32x4*)(rope + ((size_t)pos * 32 + i0) * 2);
                            float a, b;
                            a = v0[0] * r0[0] - v0[1] * r0[1]; b = v0[0] * r0[1] + v0[1] * r0[0]; v0[0] = a; v0[1] = b;
                            a = v0[2] * r0[2] - v0[3] * r0[3]; b = v0[2] * r0[3] + v0[3] * r0[2]; v0[2] = a; v0[3] = b; }
                        u32x2 w; w.x = pk2(v0[0], v0[1]); w.y = pk2(v0[2], v0[3]);
                        *(GAS u32x2*)(O + (size_t)row * 768 + c0) = w; }
                asm volatile("" ::: "memory"); }
    }
};
struct EpiMerge {
    static constexpr bool PERM = false, RESCALE = true;
    const bf16_t* ZG; bf16_t* MB;
    __device__ __forceinline__ void rescale(f32x4 (&acc)[2][2][4][2], const pg8::Unit& u, int seg, int wr, int wc, int fr, int fq) const {
        const int row0 = u.pm * 256 + wr * 64 + fr, col0 = u.pn * 256 + wc * 32 + 4 * fq;
#pragma unroll
        for (int ai = 0; ai < 2; ++ai)
#pragma unroll
            for (int m = 0; m < 4; ++m) { const bf16_t* zr = ZG + (size_t)(row0 + ai * 128 + m * 16) * NZG + seg * 1024 + col0;
#pragma unroll
                for (int bj = 0; bj < 2; ++bj)
#pragma unroll
                    for (int n = 0; n < 2; ++n) { const u32x2 ga = *(const GAS u32x2*)(zr + bj * 128 + n * 16), gb = *(const GAS u32x2*)(zr + 1024 + bj * 128 + n * 16);
                        f32x4 r;
                        r[0] = (1.0f + __expf(-bflo(gb.x))) * __builtin_amdgcn_rcpf(1.0f + __expf(-bflo(ga.x)));
                        r[1] = (1.0f + __expf(-bfhi(gb.x))) * __builtin_amdgcn_rcpf(1.0f + __expf(-bfhi(ga.x)));
                        r[2] = (1.0f + __expf(-bflo(gb.y))) * __builtin_amdgcn_rcpf(1.0f + __expf(-bflo(ga.y)));
                        r[3] = (1.0f + __expf(-bfhi(gb.y))) * __builtin_amdgcn_rcpf(1.0f + __expf(-bfhi(ga.y)));
                        acc[ai][bj][m][n] *= r; }
                asm volatile("" ::: "memory"); }
    }
    __device__ __forceinline__ void operator()(AccRef acc, const pg8::Unit& u, int wr, int wc, int fr, int fq) const {
        asm volatile("" : "+v"(fr), "+v"(fq));
        const int row0 = u.pm * 256 + wr * 64 + fr, col0 = u.pn * 256 + wc * 32 + 4 * fq;
#pragma unroll
        for (int ai = 0; ai < 2; ++ai)
#pragma unroll
            for (int m = 0; m < 4; ++m) { const int row = row0 + ai * 128 + m * 16;
#pragma unroll
                for (int bj = 0; bj < 2; ++bj)
#pragma unroll
                    for (int n = 0; n < 2; ++n) { const int c = col0 + bj * 128 + n * 16;
                        const u32x2 gw = *(const GAS u32x2*)(ZG + (size_t)row * NZG + 2 * 1024 + c);
                        f32x4 gt; gt[0] = sigmoidf_(bflo(gw.x)); gt[1] = sigmoidf_(bfhi(gw.x)); gt[2] = sigmoidf_(bflo(gw.y)); gt[3] = sigmoidf_(bfhi(gw.y));
                        const f32x4 v = gt * acc[ai][bj][m][n];
                        u32x2 w; w.x = pk2(v[0], v[1]); w.y = pk2(v[2], v[3]); *(GAS u32x2*)(MB + (size_t)row * 1024 + c) = w; } }
    }
};
__device__ __forceinline__ float dpp_ror1(float v) { return __int_as_float(__builtin_amdgcn_update_dpp(0, __float_as_int(v), 0x121, 0xf, 0xf, false)); }
__device__ __forceinline__ float dpp_ror15(float v) { return __int_as_float(__builtin_amdgcn_update_dpp(0, __float_as_int(v), 0x12f, 0xf, 0xf, false)); }
struct EpiUpConv {
    static constexpr bool PERM = true, RESCALE = false;
    bf16_t* HID; bf16_t* EDGE; const float* wc; const float* bc;
    __device__ __forceinline__ void operator()(AccRef acc, const pg8::Unit& u, int wr, int wc_, int fr, int fq) const {
        asm volatile("" : "+v"(fr), "+v"(fq));
        const int ch0 = u.pn * 128 + wc_ * 32 + 8 * fq;
#pragma unroll
        for (int n = 0; n < 2; ++n) {
            int fq2 = fq; asm volatile("" : "+v"(fq2));
            const int ch = u.pn * 128 + wc_ * 32 + 8 * fq2 + 4 * n; (void)ch0;
            const f32x4 wg0 = *(const GAS f32x4*)(wc + ch), wg1 = *(const GAS f32x4*)(wc + 5632 + ch), wg2 = *(const GAS f32x4*)(wc + 2 * 5632 + ch), bg = *(const GAS f32x4*)(bc + ch);
            const f32x4 wv0 = *(const GAS f32x4*)(wc + DFF + ch), wv1 = *(const GAS f32x4*)(wc + 5632 + DFF + ch), wv2 = *(const GAS f32x4*)(wc + 2 * 5632 + DFF + ch), bv = *(const GAS f32x4*)(bc + DFF + ch);
#pragma unroll
            for (int ai = 0; ai < 2; ++ai) {
                const int blk = ai * 2 + wr; const int rowb = u.pm * 256 + blk * 64;
                bf16_t* eg = EDGE + ((size_t)(u.pm * 4 + blk) * 4) * 5632 + ch;
                if (fr < 2) { const f32x4 g = acc[ai][0][0][n], v = acc[ai][1][0][n]; u32x2 a, b; a.x = pk2(g[0], g[1]); a.y = pk2(g[2], g[3]); b.x = pk2(v[0], v[1]); b.y = pk2(v[2], v[3]);
                    *(GAS u32x2*)(eg + (size_t)fr * 5632) = a; *(GAS u32x2*)(eg + (size_t)fr * 5632 + DFF) = b; }
                if (fr >= 14) { const f32x4 g = acc[ai][0][3][n], v = acc[ai][1][3][n]; u32x2 a, b; a.x = pk2(g[0], g[1]); a.y = pk2(g[2], g[3]); b.x = pk2(v[0], v[1]); b.y = pk2(v[2], v[3]);
                    *(GAS u32x2*)(eg + (size_t)(fr - 12) * 5632) = a; *(GAS u32x2*)(eg + (size_t)(fr - 12) * 5632 + DFF) = b; }
#pragma unroll
                for (int m = 0; m < 4; ++m) {
                    f32x4 o;
#pragma unroll
                    for (int j = 0; j < 4; ++j) {
                        const float gc = acc[ai][0][m][n][j], vc = acc[ai][1][m][n][j];
                        const float gpa = dpp_ror1(gc), gpb = dpp_ror1(acc[ai][0][m > 0 ? m - 1 : 0][n][j]), gna = dpp_ror15(gc), gnb = dpp_ror15(acc[ai][0][m < 3 ? m + 1 : 3][n][j]);
                        const float vpa = dpp_ror1(vc), vpb = dpp_ror1(acc[ai][1][m > 0 ? m - 1 : 0][n][j]), vna = dpp_ror15(vc), vnb = dpp_ror15(acc[ai][1][m < 3 ? m + 1 : 3][n][j]);
                        const float gp = fr == 0 ? gpb : gpa, gn = fr == 15 ? gnb : gna, vp = fr == 0 ? vpb : vpa, vn = fr == 15 ? vnb : vna;
                        const float cg = bg[j] + wg0[j] * gp + wg1[j] * gc + wg2[j] * gn;
                        const float cv = bv[j] + wv0[j] * vp + wv1[j] * vc + wv2[j] * vn;
                        o[j] = siluf_(cg) * cv;
                    }
                    const bool seam = (m == 0 && fr == 0) || (m == 3 && fr == 15);
                    if (!seam) { u32x2 w; w.x = pk2(o[0], o[1]); w.y = pk2(o[2], o[3]); *(GAS u32x2*)(HID + (size_t)(rowb + m * 16 + fr) * DFF + ch) = w; }
                }
            }
        }
    }
};
struct EpiCtxPart {
    static constexpr bool PERM = false, RESCALE = false;
    float* pb; int ks;
    __device__ __forceinline__ void operator()(AccRef acc, const pg8::Unit& u, int wr, int wc, int fr, int fq) const {
        asm volatile("" : "+v"(fr), "+v"(fq));
        const int bl = u.pm / 9;
        float* dst = pb + ((size_t)ks * (GB * CTXL) + bl * CTXL) * DM;
        const int r0 = wr * 64 + fr, col0 = u.pn * 256 + wc * 32 + 4 * fq;
#pragma unroll
        for (int ai = 0; ai < 2; ++ai)
#pragma unroll
            for (int m = 0; m < 4; ++m)
#pragma unroll
                for (int bj = 0; bj < 2; ++bj)
#pragma unroll
                    for (int n = 0; n < 2; ++n) *(GAS f32x4*)(dst + (size_t)(r0 + ai * 128 + m * 16) * DM + col0 + bj * 128 + n * 16) = acc[ai][bj][m][n];
    }
};
struct EpiRes {
    static constexpr bool PERM = false, RESCALE = false;
    const float* xsrc; float* xdst; const float* csrc; float* cdst; const float* mod; int mi; int grp;
    __device__ __forceinline__ void operator()(AccRef acc, const pg8::Unit& u, int wr, int wc, int fr, int fq) const {
        asm volatile("" : "+v"(fr), "+v"(fq));
        const int bl = u.pm / 9, j = u.pm % 9, b = grp * GB + bl;
        const float* src; float* dst; int mrow;
        if (j == 0) { src = csrc + (size_t)b * CTXL * DM; dst = cdst + (size_t)b * CTXL * DM; mrow = 16; }
        else { const size_t o = ((size_t)b * SEQ + (j - 1) * 256) * DM; src = xsrc + o; dst = xdst + o; mrow = b; }
        const float* mv = mod + mrow * 6144 + mi * 1024;
        const int r0 = wr * 64 + fr, col0 = u.pn * 256 + wc * 32 + 4 * fq;
        f32x4 mg[2][2];
#pragma unroll
        for (int bj = 0; bj < 2; ++bj)
#pragma unroll
            for (int n = 0; n < 2; ++n) mg[bj][n] = *(const GAS f32x4*)(mv + col0 + bj * 128 + n * 16);
#pragma unroll
        for (int ai = 0; ai < 2; ++ai)
#pragma unroll
            for (int m = 0; m < 4; ++m) { const size_t ro = (size_t)(r0 + ai * 128 + m * 16) * DM + col0;
#pragma unroll
                for (int bj = 0; bj < 2; ++bj)
#pragma unroll
                    for (int n = 0; n < 2; ++n) { const f32x4 xo = *(const GAS f32x4*)(src + ro + bj * 128 + n * 16);
                        *(GAS f32x4*)(dst + ro + bj * 128 + n * 16) = xo + mg[bj][n] * acc[ai][bj][m][n]; } }
    }
};

#define XB_TMO      128
#define XB_XCNT(j)  (256  + 64 * (j))
#define XB_XSUB(j)  (1280 + 64 * (j))
#define XB_XGEN(j)  (2304 + 64 * (j))
#define XB_TOP      3328
#define XB_TOPGEN   3392
#define XCD_BAR_WORDS 3456
#define XB_SPIN_CAP (1u << 20)
__device__ __forceinline__ unsigned xb_ld(unsigned* p)              { return __hip_atomic_load(p, __ATOMIC_RELAXED, __HIP_MEMORY_SCOPE_AGENT); }
__device__ __forceinline__ unsigned xb_add(unsigned* p, unsigned v) { return __hip_atomic_fetch_add(p, v, __ATOMIC_RELAXED, __HIP_MEMORY_SCOPE_AGENT); }
__device__ __forceinline__ unsigned xb_xcc_id() { return (unsigned)__builtin_amdgcn_s_getreg((3 << 11) | 20) & 0xFu; }
#define XB_SPIN(cond, bar) do { unsigned _sp = 0; while (cond) { __builtin_amdgcn_s_sleep(1); \
    if ((++_sp & 255u) == 0u) { if (xb_ld(&(bar)[XB_TMO])) break; if (_sp > XB_SPIN_CAP) { xb_add(&(bar)[XB_TMO], 1u); break; } } } } while (0)
__device__ __forceinline__ void xcd_barrier_complete(unsigned* bar, unsigned x, unsigned& nloc, unsigned& nx) {
    const unsigned G = gridDim.x;
    unsigned sum, cnt, mine, sp = 0u;
    for (;;) {
        sum = 0u; cnt = 0u; mine = 0u;
#pragma unroll
        for (unsigned j = 0; j < 16; ++j) { const unsigned c = xb_ld(&bar[XB_XCNT(j)]); sum += c; cnt += (c > 0u) ? 1u : 0u; mine = (j == x) ? c : mine; }
        if (sum == G) break;
        __builtin_amdgcn_s_sleep(1);
        if ((++sp & 255u) == 0u) { if (xb_ld(&bar[XB_TMO])) break; if (sp > XB_SPIN_CAP) { xb_add(&bar[XB_TMO], 1u); break; } }
    }
    nloc = mine > 0u ? mine : 1u; nx = cnt > 0u ? cnt : 1u;
}
__device__ __forceinline__ void xcd_barrier(unsigned* bar, volatile LAS unsigned* st, bool leader) {
    asm volatile("s_waitcnt vmcnt(0)" ::: "memory");
    __syncthreads();
    if (leader) {
        __builtin_amdgcn_s_waitcnt(0);
        const unsigned x = xb_xcc_id();
        unsigned nloc = st[0], nx = st[1];
        if (nloc == 0u) { xcd_barrier_complete(bar, x, nloc, nx); st[0] = nloc; st[1] = nx; }
        const unsigned old = xb_add(&bar[XB_XSUB(x)], 1u);
        const unsigned gen = old / nloc;
        if (old + 1u == (gen + 1u) * nloc) {
            __builtin_amdgcn_fence(__ATOMIC_RELEASE, "agent");
            asm volatile("s_waitcnt vmcnt(0)" ::: "memory");
            const unsigned og = xb_add(&bar[XB_TOP], 1u);
            const unsigned tg = og / nx;
            if (og + 1u == (tg + 1u) * nx) xb_add(&bar[XB_TOPGEN], 1u);
            else XB_SPIN(xb_ld(&bar[XB_TOPGEN]) == tg, bar);
            __builtin_amdgcn_fence(__ATOMIC_ACQUIRE, "agent");
            xb_add(&bar[XB_XGEN(x)], 1u);
            asm volatile("s_waitcnt vmcnt(0)" ::: "memory");
        } else {
            XB_SPIN(xb_ld(&bar[XB_XGEN(x)]) == gen, bar);
            __builtin_amdgcn_fence(__ATOMIC_ACQUIRE, "agent");
            asm volatile("s_waitcnt vmcnt(0)" ::: "memory");
        }
    }
    __syncthreads();
}

struct Ctx {
    LAS unsigned char* lds; int tid, lane, wave;
    const Params* P; unsigned char* ws;
};

__device__ __forceinline__ int inmap(int n) {
    if (n < 2048) return n;
    if (n < 2432) return 2064 + (n - 2048);
    if (n < 2688) return 2448 + (n - 2432);
    if (n < 2752) return 2704 + (n - 2688);
    if (n < 2768) return 2048 + (n - 2752);
    if (n < 2816) return -1;
    if (n < 3328) return 2768 + (n - 2816);
    if (n < 3840) return 3280 + (n - 3328);
    return 3792 + (n - 3840);
}

__device__ __forceinline__ void wprep_tile(const Ctx& F, const float* W, int ldw, int K, bf16_t* Bt, int n0, int k0, int isin, const float* kscale, int ldb = 0) {
    if (ldb == 0) ldb = K;
    LAS float* tile = (LAS float*)F.lds;
    const int t = F.tid;
    const int nn = t & 63, kb = t >> 6;
    const int nq = n0 + nn;
    const int sc = isin == 1 ? inmap(nq) : isin == 2 ? (((nq & 511) >> 7) * 256 + (nq >> 9) * 128 + (nq & 127)) : isin == 3 ? (((nq >> 7) & 1) * DFF + (nq >> 8) * 128 + (nq & 127)) : nq;
#pragma unroll
    for (int i = 0; i < 8; ++i) { const int kk = i * 8 + kb; float v = sc >= 0 ? W[(size_t)(k0 + kk) * ldw + sc] : 0.f; if (kscale) v *= kscale[k0 + kk]; tile[kk * 65 + nn] = v; }
    __syncthreads();
    const int n = t >> 3, c = t & 7;
    const LAS float* s = tile + (8 * c) * 65 + n;
    u32x4 o; o.x = pk2(s[0], s[65]); o.y = pk2(s[130], s[195]); o.z = pk2(s[260], s[325]); o.w = pk2(s[390], s[455]);
    *(GAS u32x4*)(Bt + (size_t)(n0 + n) * ldb + k0 + 8 * c) = o;
}

__device__ __forceinline__ void phase_prep(const Ctx& F, int l) {
    const Params& P = *F.P; unsigned char* ws = F.ws;
    const int NWT = 1728 + 72 + 64 + 384 + 256 + 1408 + 704;
    const int total = NWT + (l == 0 ? 192 + 128 : 0);
    for (int it0 = blockIdx.x; it0 < total; it0 += gridDim.x) {
        __syncthreads();
        int it = it0;
        if (it < NWT) {
            if (it < 1728) { wprep_tile(F, P.in[7] + (size_t)l * 1024 * 6864, 6864, 1024, (bf16_t*)(ws + WS_WIN), (it / 16) * 64, (it % 16) * 64, 1, nullptr); continue; } it -= 1728;
            if (it < 72) { wprep_tile(F, P.in[13] + (size_t)l * 384 * 768, 768, 384, (bf16_t*)(ws + WS_WUQ), (it / 6) * 64, (it % 6) * 64, 0, P.in[12] + l * 384); continue; } it -= 72;
            if (it < 64) { wprep_tile(F, P.in[15] + (size_t)l * 256 * 1024, 1024, 256, (bf16_t*)(ws + WS_WUKV), (it / 4) * 64, (it % 4) * 64, 2, P.in[14] + l * 256); continue; } it -= 64;
            if (it < 384) { const int gb = it / 128, r = it % 128; wprep_tile(F, P.in[19] + ((size_t)l * 3 + gb) * 512 * 1024, 1024, 512, (bf16_t*)(ws + WS_WBR) + (size_t)gb * 512, (r / 8) * 64, (r % 8) * 64, 0, nullptr, 1536); continue; } it -= 384;
            if (it < 256) { wprep_tile(F, P.in[20] + (size_t)l * 1024 * 1024, 1024, 1024, (bf16_t*)(ws + WS_WOUT), (it / 16) * 64, (it % 16) * 64, 0, nullptr); continue; } it -= 256;
            if (it < 1408) { wprep_tile(F, P.in[22] + (size_t)l * 1024 * 5632, 5632, 1024, (bf16_t*)(ws + WS_WUP), (it / 16) * 64, (it % 16) * 64, 3, nullptr); continue; } it -= 1408;
            wprep_tile(F, P.in[25] + (size_t)l * 2816 * 1024, 1024, 2816, (bf16_t*)(ws + WS_WDN), (it / 44) * 64, (it % 44) * 64, 0, nullptr); continue;
        }
        it -= NWT;
        if (it < 192) {
            const int l2 = it / 96, nb = it % 96;
            LAS float* cond = (LAS float*)F.lds; LAS float* red = cond + 17 * 1024;
            for (int i = F.tid; i < 17 * 1024; i += NTHREADS) { const int r = i >> 10, k = i & 1023; const float cv = r < 16 ? P.in[1][r * 1024 + k] : P.in[3][k]; cond[i] = siluf_(cv); }
            __syncthreads();
            const int cc = F.tid & 63, ks = F.tid >> 6; const int col = nb * 64 + cc;
            const float* wa = P.in[4] + (size_t)l2 * 1024 * 6144 + col;
            float a[17];
#pragma unroll
            for (int r = 0; r < 17; ++r) a[r] = 0.f;
            for (int k = ks * 128; k < ks * 128 + 128; ++k) { const float w = wa[(size_t)k * 6144];
#pragma unroll
                for (int r = 0; r < 17; ++r) a[r] += cond[r * 1024 + k] * w; }
#pragma unroll
            for (int r = 0; r < 17; ++r) red[(ks * 17 + r) * 64 + cc] = a[r];
            __syncthreads();
            for (int i = F.tid; i < 17 * 64; i += NTHREADS) { const int r = i >> 6, c2 = i & 63; float s = P.in[5][l2 * 6144 + nb * 64 + c2];
#pragma unroll
                for (int q = 0; q < 8; ++q) s += red[(q * 17 + r) * 64 + c2];
                ((float*)(ws + WS_MOD))[((size_t)l2 * 17 + r) * 6144 + nb * 64 + c2] = s; }
            continue;
        }
        it -= 192;
        {
            const int e = it * NTHREADS + F.tid; const int pos = e >> 5, i = e & 31;
            const float inv = exp2f(-(float)(i & 15) * (13.287712379549449f / 16.0f));
            const float ang = (float)(i < 16 ? (pos >> 6) : (pos & 63)) * inv;
            f32x2 cs; cs.x = cosf(ang); cs.y = sinf(ang);
            ((GAS f32x2*)(ws + WS_ROPE))[e] = cs;
        }
    }
}

__device__ __forceinline__ void phase_norm(const Ctx& F, int l, int g, int which) {
    const Params& P = *F.P; unsigned char* ws = F.ws;
    const float* gvec = (which ? P.in[21] : P.in[6]) + l * 1024;
    const float* mod = (const float*)(ws + WS_MOD) + (size_t)l * 17 * 6144;
    const float* xin = (l == 0 && !which) ? P.in[0] : P.out;
    const float* cin = (l == 0 && !which) ? P.in[2] : (const float*)(ws + WS_CTXS);
    bf16_t* H = (bf16_t*)(ws + WS_H);
    for (int r = blockIdx.x * 8 + F.wave; r < T; r += gridDim.x * 8) {
        const int bl = r / SEQT, p = r % SEQT, b = g * GB + bl;
        const float* src; int mrow;
        if (p < CTXL) { if (which && l == 1) continue; src = cin + ((size_t)b * CTXL + p) * DM; mrow = 16; }
        else { src = xin + ((size_t)b * SEQ + p - CTXL) * DM; mrow = b; }
        const float* sh = mod + mrow * 6144 + (which ? 3 : 0) * 1024; const float* sc = sh + 1024;
        f32x4 v[4]; float s = 0.f;
#pragma unroll
        for (int j = 0; j < 4; ++j) { v[j] = ((const GAS f32x4*)src)[F.lane + 64 * j]; s += v[j][0] * v[j][0] + v[j][1] * v[j][1] + v[j][2] * v[j][2] + v[j][3] * v[j][3]; }
        if (l == 0 && !which && p < CTXL) {
            float* cs = (float*)(ws + WS_CTXS) + ((size_t)b * CTXL + p) * DM;
#pragma unroll
            for (int j = 0; j < 4; ++j) ((GAS f32x4*)cs)[F.lane + 64 * j] = v[j]; }
        if (l == 0 && which && p < CTXL) {
            const float* pb = (const float*)(ws + WS_ZG) + ((size_t)bl * CTXL + p) * DM; const float* m2 = mod + 16 * 6144 + 2 * 1024; float* cs = (float*)(ws + WS_CTXS) + ((size_t)b * CTXL + p) * DM;
            s = 0.f;
#pragma unroll
            for (int j = 0; j < 4; ++j) { const int c = (F.lane + 64 * j) * 4; f32x4 a = *(const GAS f32x4*)(pb + c);
#pragma unroll
                for (int k2 = 1; k2 < 4; ++k2) a += *(const GAS f32x4*)(pb + (size_t)k2 * (GB * CTXL) * DM + c);
                v[j] += *(const GAS f32x4*)(m2 + c) * a; *(GAS f32x4*)(cs + c) = v[j];
                s += v[j][0] * v[j][0] + v[j][1] * v[j][1] + v[j][2] * v[j][2] + v[j][3] * v[j][3]; } }
        const float rstd = rsqrtf(wave_sum(s, F.lane) * (1.0f / DM) + EPS);
#pragma unroll
        for (int j = 0; j < 4; ++j) { const int c = (F.lane + 64 * j) * 4;
            const f32x4 gv = *(const GAS f32x4*)(gvec + c), sv = *(const GAS f32x4*)(sc + c), hv = *(const GAS f32x4*)(sh + c);
            const f32x4 y = v[j] * rstd * gv * (sv + 1.0f) + hv;
            u32x2 w; w.x = pk2(y[0], y[1]); w.y = pk2(y[2], y[3]);
            *(GAS u32x2*)(H + (size_t)r * DM + c) = w; }
    }
}

__device__ __forceinline__ void phase_ctxsum(const Ctx& F, int g) {
    unsigned char* ws = F.ws;
    const float* m5 = (const float*)(ws + WS_MOD) + 16 * 6144 + 5 * 1024;
    for (int r = blockIdx.x * 8 + F.wave; r < GB * CTXL; r += gridDim.x * 8) {
        const float* pb = (const float*)(ws + WS_Z1) + (size_t)r * DM; float* cs = (float*)(ws + WS_CTXS) + ((size_t)g * GB * CTXL + r) * DM;
#pragma unroll
        for (int j = 0; j < 4; ++j) { const int c = (F.lane + 64 * j) * 4; f32x4 a = *(const GAS f32x4*)(pb + c);
#pragma unroll
            for (int k2 = 1; k2 < 8; ++k2) a += *(const GAS f32x4*)(pb + (size_t)k2 * (GB * CTXL) * DM + c);
            *(GAS f32x4*)(cs + c) = *(const GAS f32x4*)(cs + c) + *(const GAS f32x4*)(m5 + c) * a; }
    }
}

__device__ __forceinline__ void phase_final(const Ctx& F, int r0, int r1, int wlo, int wcnt) {
    const Params& P = *F.P;
    const float* gvec = P.in[26];
    if ((int)blockIdx.x < wlo || (int)blockIdx.x >= wlo + wcnt) return;
    for (int r = r0 + ((int)blockIdx.x - wlo) * 8 + F.wave; r < r1; r += wcnt * 8) {
        float* row = P.out + (size_t)r * DM;
        f32x4 v[4]; float s = 0.f;
#pragma unroll
        for (int j = 0; j < 4; ++j) { v[j] = ((const GAS f32x4*)row)[F.lane + 64 * j]; s += v[j][0] * v[j][0] + v[j][1] * v[j][1] + v[j][2] * v[j][2] + v[j][3] * v[j][3]; }
        const float rstd = rsqrtf(wave_sum(s, F.lane) * (1.0f / DM) + EPS);
#pragma unroll
        for (int j = 0; j < 4; ++j) { const int c = (F.lane + 64 * j) * 4; const f32x4 gv = *(const GAS f32x4*)(gvec + c);
            ((GAS f32x4*)row)[F.lane + 64 * j] = v[j] * rstd * gv; }
    }
}

__device__ __forceinline__ void phase_rowstats(const Ctx& F, int l) {
    const Params& P = *F.P; unsigned char* ws = F.ws;
    bf16_t* QC = (bf16_t*)(ws + WS_H);
    const float* cwt = P.in[8] + (size_t)l * 3 * 1024; const float* cbs = P.in[9] + (size_t)l * 1024;
    const bf16_t* Z1 = (const bf16_t*)(ws + WS_Z1); float* RS = (float*)(ws + WS_RS); bf16_t* KR = (bf16_t*)(ws + WS_KR);
    const float* rope = (const float*)(ws + WS_ROPE);
    for (int r = blockIdx.x * 8 + F.wave; r < T; r += gridDim.x * 8) {
        const bf16_t* zr = Z1 + (size_t)r * NZ1;
        float sq = 0.f, sk = 0.f;
#pragma unroll
        for (int j = 0; j < 3; ++j) { const unsigned w = *(const GAS unsigned*)(zr + ZCQ + j * 128 + 2 * F.lane); const float a = bflo(w), b = bfhi(w); sq += a * a + b * b; }
#pragma unroll
        for (int j = 0; j < 2; ++j) { const unsigned w = *(const GAS unsigned*)(zr + ZCKV + j * 128 + 2 * F.lane); const float a = bflo(w), b = bfhi(w); sk += a * a + b * b; }
        sq = wave_sum(sq, F.lane); sk = wave_sum(sk, F.lane);
        if (F.lane == 0) { RS[r * 2] = rsqrtf(sq * (1.0f / 384.0f) + EPS); RS[r * 2 + 1] = rsqrtf(sk * (1.0f / 256.0f) + EPS); }
        if (F.lane < 32) { const unsigned w = *(const GAS unsigned*)(zr + ZKR + 2 * F.lane); float x1 = bflo(w), x2 = bfhi(w);
            const int p = r % SEQT;
            if (p >= CTXL) { const f32x2 cs = ((const GAS f32x2*)rope)[(size_t)(p - CTXL) * 32 + F.lane]; const float a = x1 * cs.x - x2 * cs.y, b = x1 * cs.y + x2 * cs.x; x1 = a; x2 = b; }
            *(GAS unsigned*)(KR + (size_t)r * 64 + 2 * F.lane) = pk2(x1, x2); }
        {
            const int p = r % SEQT; const bool hp = (p != 0) && (p != CTXL), hn = (p != CTXL - 1) && (p != SEQT - 1);
            const u32x4 z4 = (u32x4){0u, 0u, 0u, 0u};
#pragma unroll
            for (int which = 0; which < 2; ++which) { const int col = which * 512 + F.lane * 8;
                const u32x4 xp = hp ? *(const GAS u32x4*)(zr - NZ1 + col) : z4, xc = *(const GAS u32x4*)(zr + col), xn = hn ? *(const GAS u32x4*)(zr + NZ1 + col) : z4;
                const float osc = which ? 0.08838834764831845f : 1.0f;
                float y[8];
#pragma unroll
                for (int e = 0; e < 8; ++e) { const unsigned wp = e < 2 ? xp.x : e < 4 ? xp.y : e < 6 ? xp.z : xp.w, wc_ = e < 2 ? xc.x : e < 4 ? xc.y : e < 6 ? xc.z : xc.w, wn = e < 2 ? xn.x : e < 4 ? xn.y : e < 6 ? xn.z : xn.w;
                    const float a = cbs[col + e] + cwt[col + e] * ((e & 1) ? bfhi(wp) : bflo(wp)) + cwt[1024 + col + e] * ((e & 1) ? bfhi(wc_) : bflo(wc_)) + cwt[2048 + col + e] * ((e & 1) ? bfhi(wn) : bflo(wn));
                    y[e] = siluf_(a) * osc; }
                u32x4 wv; wv.x = pk2(y[0], y[1]); wv.y = pk2(y[2], y[3]); wv.z = pk2(y[4], y[5]); wv.w = pk2(y[6], y[7]);
                *(GAS u32x4*)(QC + (size_t)r * 1024 + col) = wv; }
        }
    }
}

__device__ __forceinline__ void phase_mout(const Ctx& F, int l) {
    const Params& P = *F.P; unsigned char* ws = F.ws;
    const bf16_t* Z1 = (const bf16_t*)(ws + WS_Z1); const bf16_t* HF = (const bf16_t*)(ws + WS_HF); const bf16_t* HB = (const bf16_t*)(ws + WS_HB);
    bf16_t* Y = (bf16_t*)(ws + WS_Y); const float* gh = P.in[11] + l * 512;
    for (int r = blockIdx.x * 8 + F.wave; r < T; r += gridDim.x * 8) {
        if (l == 1 && (r % SEQT) < CTXL) continue;
        const int c = 8 * F.lane;
        const u32x4 a = *(const GAS u32x4*)(HF + (size_t)r * 512 + c), b = *(const GAS u32x4*)(HB + (size_t)r * 512 + c), o = *(const GAS u32x4*)(Z1 + (size_t)r * NZ1 + ZO + c);
        float h[8];
        h[0] = bflo(a.x) + bflo(b.x); h[1] = bfhi(a.x) + bfhi(b.x); h[2] = bflo(a.y) + bflo(b.y); h[3] = bfhi(a.y) + bfhi(b.y);
        h[4] = bflo(a.z) + bflo(b.z); h[5] = bfhi(a.z) + bfhi(b.z); h[6] = bflo(a.w) + bflo(b.w); h[7] = bfhi(a.w) + bfhi(b.w);
        float s = 0.f;
#pragma unroll
        for (int i = 0; i < 8; ++i) s += h[i] * h[i];
        s += shx(s, 1, F.lane); s += shx(s, 2, F.lane); s += shx(s, 4, F.lane); s += shx(s, 8, F.lane);
        const float rstd = rsqrtf(s * (1.0f / 128.0f) + EPS);
        float og[8];
        og[0] = bflo(o.x); og[1] = bfhi(o.x); og[2] = bflo(o.y); og[3] = bfhi(o.y); og[4] = bflo(o.z); og[5] = bfhi(o.z); og[6] = bflo(o.w); og[7] = bfhi(o.w);
        const f32x4 g0 = *(const GAS f32x4*)(gh + c), g1 = *(const GAS f32x4*)(gh + c + 4);
        float y[8];
#pragma unroll
        for (int i = 0; i < 8; ++i) y[i] = sigmoidf_(og[i]) * (h[i] * rstd * (i < 4 ? g0[i & 3] : g1[i & 3]));
        u32x4 w; w.x = pk2(y[0], y[1]); w.y = pk2(y[2], y[3]); w.z = pk2(y[4], y[5]); w.w = pk2(y[6], y[7]);
        *(GAS u32x4*)(Y + (size_t)r * 1536 + c) = w;
    }
}

__device__ __forceinline__ void phase_ffedge(const Ctx& F, int l) {
    const Params& P = *F.P; unsigned char* ws = F.ws;
    const bf16_t* EDGE = (const bf16_t*)(ws + WS_EDGE); bf16_t* Hd = (bf16_t*)(ws + WS_HID);
    const float* wc = P.in[23] + (size_t)l * 3 * 5632; const float* bc = P.in[24] + (size_t)l * 5632;
    const int ntask = 72 * 4 * 2 * 704;
    for (int q = blockIdx.x * NTHREADS + F.tid; q < ntask; q += gridDim.x * NTHREADS) {
        const int cg4 = q % 704, e = q / 704; const int bot = e & 1, blk = (e >> 1) & 3, tile = e >> 3; const int c = cg4 * 4;
        const int j9 = tile % 9;
        if (l == 1 && j9 == 0) continue;
        const bf16_t* eb = EDGE + ((size_t)(tile * 4 + blk) * 4) * 5632;
        const bf16_t *rp, *rc, *rn; bool hp = true, hn = true;
        if (!bot) { rc = eb; rn = eb + 5632;
            if (blk > 0) rp = eb - 5632;
            else { hp = !(j9 == 0 || j9 == 1); rp = eb - 5632; }
        } else { rc = eb + 3 * 5632; rp = eb + 2 * 5632;
            if (blk < 3) rn = eb + 4 * 5632;
            else { hn = !(j9 == 0 || j9 == 8); rn = eb + 4 * 5632; }
        }
        const u32x2 z2 = (u32x2){0u, 0u};
        const u32x2 gp = hp ? *(const GAS u32x2*)(rp + c) : z2, gc = *(const GAS u32x2*)(rc + c), gn = hn ? *(const GAS u32x2*)(rn + c) : z2;
        const u32x2 vp = hp ? *(const GAS u32x2*)(rp + DFF + c) : z2, vc = *(const GAS u32x2*)(rc + DFF + c), vn = hn ? *(const GAS u32x2*)(rn + DFF + c) : z2;
        const f32x4 wg0 = *(const GAS f32x4*)(wc + c), wg1 = *(const GAS f32x4*)(wc + 5632 + c), wg2 = *(const GAS f32x4*)(wc + 2 * 5632 + c), bg = *(const GAS f32x4*)(bc + c);
        const f32x4 wv0 = *(const GAS f32x4*)(wc + DFF + c), wv1 = *(const GAS f32x4*)(wc + 5632 + DFF + c), wv2 = *(const GAS f32x4*)(wc + 2 * 5632 + DFF + c), bv = *(const GAS f32x4*)(bc + DFF + c);
        float o[4];
#pragma unroll
        for (int j = 0; j < 4; ++j) {
            const unsigned a0 = j < 2 ? gp.x : gp.y, a1 = j < 2 ? gc.x : gc.y, a2 = j < 2 ? gn.x : gn.y, b0 = j < 2 ? vp.x : vp.y, b1 = j < 2 ? vc.x : vc.y, b2 = j < 2 ? vn.x : vn.y;
            const float cgv = bg[j] + wg0[j] * ((j & 1) ? bfhi(a0) : bflo(a0)) + wg1[j] * ((j & 1) ? bfhi(a1) : bflo(a1)) + wg2[j] * ((j & 1) ? bfhi(a2) : bflo(a2));
            const float cvv = bv[j] + wv0[j] * ((j & 1) ? bfhi(b0) : bflo(b0)) + wv1[j] * ((j & 1) ? bfhi(b1) : bflo(b1)) + wv2[j] * ((j & 1) ? bfhi(b2) : bflo(b2));
            o[j] = siluf_(cgv) * cvv;
        }
        u32x2 w; w.x = pk2(o[0], o[1]); w.y = pk2(o[2], o[3]);
        *(GAS u32x2*)(Hd + (size_t)(tile * 256 + blk * 64 + (bot ? 63 : 0)) * DFF + c) = w;
    }
}

constexpr int LP = 136;
__device__ __forceinline__ void sgu_unit(const Ctx& F_, int l, int bl, int c, int gi) {
    Ctx F = F_; { int t_ = F_.lane; asm volatile("" : "+v"(t_)); int w_ = F_.wave; asm volatile("" : "+s"(w_)); F.lane = t_; F.wave = w_; F.tid = w_ * 64 + t_; }
    const Params& P = *F.P; unsigned char* ws = F.ws;
    const bf16_t* Z1 = (const bf16_t*)(ws + WS_Z1); bf16_t* Y = (bf16_t*)(ws + WS_Y);
    LAS bf16_t* Ws = (LAS bf16_t*)F.lds; LAS bf16_t* VnT = Ws + 128 * LP;
    const int R0 = bl * SEQT + c * 128;
    const int t = F.tid, s = t >> 2, cb = (t & 3) * 32;
    {
        const float* wsrc = P.in[17] + (((size_t)l * 4 + gi) * 128 + s) * 128 + cb;
#pragma unroll
        for (int i = 0; i < 4; ++i) { const f32x4 a = *(const GAS f32x4*)(wsrc + i * 8), b = *(const GAS f32x4*)(wsrc + i * 8 + 4);
            u32x4 w; w.x = pk2(a[0], a[1]); w.y = pk2(a[2], a[3]); w.z = pk2(b[0], b[1]); w.w = pk2(b[2], b[3]);
            *(LAS u32x4*)(Ws + s * LP + cb + i * 8) = w; }
        const bf16_t* vsrc = Z1 + (size_t)(R0 + s) * NZ1 + ZS + gi * 128 + cb;
        float v[32]; float sq = 0.f;
#pragma unroll
        for (int i = 0; i < 4; ++i) { const u32x4 w = *(const GAS u32x4*)(vsrc + i * 8);
            v[i * 8 + 0] = geluf_(bflo(w.x)); v[i * 8 + 1] = geluf_(bfhi(w.x)); v[i * 8 + 2] = geluf_(bflo(w.y)); v[i * 8 + 3] = geluf_(bfhi(w.y));
            v[i * 8 + 4] = geluf_(bflo(w.z)); v[i * 8 + 5] = geluf_(bfhi(w.z)); v[i * 8 + 6] = geluf_(bflo(w.w)); v[i * 8 + 7] = geluf_(bfhi(w.w)); }
#pragma unroll
        for (int i = 0; i < 32; ++i) sq += v[i] * v[i];
        sq += shx(sq, 1, F.lane); sq += shx(sq, 2, F.lane);
        const float rstd = rsqrtf(sq * (1.0f / 128.0f) + EPS);
        const float* gs = P.in[16] + l * 512 + gi * 128 + cb;
#pragma unroll
        for (int i = 0; i < 32; ++i) VnT[(cb + i) * LP + s] = f2bf(v[i] * rstd * gs[i]);
    }
    __syncthreads();
    const int fr = F.lane & 15, fq = F.lane >> 4, w = F.wave;
    f32x4 acc[8];
#pragma unroll
    for (int ct = 0; ct < 8; ++ct) acc[ct] = (f32x4){0.f, 0.f, 0.f, 0.f};
#pragma unroll
    for (int kk = 0; kk < 4; ++kk) {
        const bf16x8 bfr = *(const LAS bf16x8*)(Ws + (w * 16 + fr) * LP + kk * 32 + fq * 8);
#pragma unroll
        for (int ct = 0; ct < 8; ++ct) { const bf16x8 afr = *(const LAS bf16x8*)(VnT + (ct * 16 + fr) * LP + kk * 32 + fq * 8); acc[ct] = mfma16(afr, bfr, acc[ct]); }
    }
    const int tt = w * 16 + fr; const float bsv = P.in[18][((size_t)l * 4 + gi) * 128 + tt];
    const bf16_t* usrc = Z1 + (size_t)(R0 + tt) * NZ1 + ZU + gi * 128; bf16_t* yd = Y + (size_t)(R0 + tt) * 1536 + 1024 + gi * 128;
#pragma unroll
    for (int ct = 0; ct < 8; ++ct) { const int ch = ct * 16 + fq * 4; const u32x2 uw = *(const GAS u32x2*)(usrc + ch);
        const float o0 = geluf_(bflo(uw.x)) * (acc[ct][0] + bsv), o1 = geluf_(bfhi(uw.x)) * (acc[ct][1] + bsv), o2 = geluf_(bflo(uw.y)) * (acc[ct][2] + bsv), o3 = geluf_(bfhi(uw.y)) * (acc[ct][3] + bsv);
        u32x2 ow; ow.x = pk2(o0, o1); ow.y = pk2(o2, o3); *(GAS u32x2*)(yd + ch) = ow; }
}

constexpr int KP = 208, VP = 80;
constexpr int ATT_BUF = (64 * KP + 128 * VP) * 2;
constexpr int ANT = 2;
__device__ __forceinline__ void attn_unit(const Ctx& F_, int bl, int h, int qrow0, int nkt) {
    Ctx F = F_; { int t_ = F_.lane; asm volatile("" : "+v"(t_)); int w_ = F_.wave; asm volatile("" : "+s"(w_)); F.lane = t_; F.wave = w_; F.tid = w_ * 64 + t_; }
    unsigned char* ws = F.ws;
    const bf16_t* QA = (const bf16_t*)(ws + WS_QA);
    const char* KNb = (const char*)(ws + WS_KV) + ((size_t)bl * SEQT * 512 + h * 128) * 2;
    const char* KRb = (const char*)(ws + WS_KR) + (size_t)bl * SEQT * 64 * 2;
    const char* VTb = (const char*)(ws + WS_KV) + ((size_t)T * 512 + (size_t)((bl * 4 + h) * 128) * SEQT) * 2;
    bf16_t* Y = (bf16_t*)(ws + WS_Y);
    const int t = F.tid, fr = F.lane & 15, fq = F.lane >> 4, w = F.wave;
    unsigned kofs[4]; int ksel[4]; unsigned vofs[3];
#pragma unroll
    for (int i = 0; i < 4; ++i) { const int q = i * 512 + t; const int row = q / 26, pc = q % 26; const int pcc = pc >= 24 ? 0 : pc;
        ksel[i] = pcc >= 16; kofs[i] = pcc >= 16 ? (unsigned)(row * 64 + (pcc - 16) * 8) * 2u : (unsigned)(row * 512 + pcc * 8) * 2u; }
#pragma unroll
    for (int i = 0; i < 3; ++i) { const int q = i * 512 + t; const int row = q / 10, pc = q % 10; vofs[i] = (unsigned)(row * SEQT + (pc >= 8 ? 0 : pc) * 8) * 2u; }
#define ATT_DMA(kt, bufi) do { LAS unsigned char* kb_ = F.lds + (bufi) * ATT_BUF; const char* kn_ = KNb + (size_t)(kt) * 64 * 512 * 2; const char* kr_ = KRb + (size_t)(kt) * 64 * 64 * 2; const char* vt_ = VTb + (size_t)(kt) * 64 * 2; \
        _Pragma("unroll") for (int i_ = 0; i_ < 4; ++i_) { if (i_ < 3 || t < 128) __builtin_amdgcn_global_load_lds((const GAS unsigned*)((ksel[i_] ? kr_ : kn_) + kofs[i_]), (LAS unsigned*)(kb_ + (i_ * 512 + w * 64) * 16), 16, 0, 0); } \
        _Pragma("unroll") for (int i_ = 0; i_ < 3; ++i_) { if (i_ < 2 || t < 256) __builtin_amdgcn_global_load_lds((const GAS unsigned*)(vt_ + vofs[i_]), (LAS unsigned*)(kb_ + 64 * KP * 2 + (i_ * 512 + w * 64) * 16), 16, 0, 0); } } while (0)
    ATT_DMA(0, 0);
    bf16x8 qf[ANT][6];
#pragma unroll
    for (int tt = 0; tt < ANT; ++tt)
#pragma unroll
        for (int kk = 0; kk < 6; ++kk) qf[tt][kk] = *(const GAS bf16x8*)(QA + (size_t)(qrow0 + w * (16 * ANT) + tt * 16 + fr) * 768 + h * 192 + kk * 32 + fq * 8);
    f32x4 o[8][ANT];
#pragma unroll
    for (int et = 0; et < 8; ++et)
#pragma unroll
        for (int tt = 0; tt < ANT; ++tt) o[et][tt] = (f32x4){0.f, 0.f, 0.f, 0.f};
    float mrun[ANT], lrun[ANT];
#pragma unroll
    for (int tt = 0; tt < ANT; ++tt) { mrun[tt] = -1e30f; lrun[tt] = 0.f; }
    asm volatile("s_waitcnt vmcnt(0)" ::: "memory");
    __syncthreads();
    for (int kt = 0; kt < nkt; ++kt) {
        if (kt + 1 < nkt) ATT_DMA(kt + 1, (kt + 1) & 1);
        const LAS bf16_t* Ks = (const LAS bf16_t*)(F.lds + (kt & 1) * ATT_BUF); const LAS bf16_t* Vt = Ks + 64 * KP;
        f32x4 s[4][ANT];
#pragma unroll
        for (int st = 0; st < 4; ++st)
#pragma unroll
            for (int tt = 0; tt < ANT; ++tt) s[st][tt] = (f32x4){0.f, 0.f, 0.f, 0.f};
        bf16x8 kf[2][4];
#pragma unroll
        for (int st = 0; st < 4; ++st) kf[0][st] = *(const LAS bf16x8*)(Ks + (st * 16 + fr) * KP + fq * 8);
#pragma unroll
        for (int kk = 0; kk < 6; ++kk) {
            if (kk < 5) {
#pragma unroll
                for (int st = 0; st < 4; ++st) kf[(kk + 1) & 1][st] = *(const LAS bf16x8*)(Ks + (st * 16 + fr) * KP + (kk + 1) * 32 + fq * 8);
            }
            __builtin_amdgcn_sched_barrier(0);
#pragma unroll
            for (int st = 0; st < 4; ++st)
#pragma unroll
                for (int tt = 0; tt < ANT; ++tt) s[st][tt] = mfma16(kf[kk & 1][st], qf[tt][kk], s[st][tt]);
            __builtin_amdgcn_sched_barrier(0);
        }
        bf16x8 vf[2][4];
#pragma unroll
        for (int e4 = 0; e4 < 4; ++e4) vf[0][e4] = *(const LAS bf16x8*)(Vt + (e4 * 16 + fr) * VP + fq * 8);
        bf16x8 pf[ANT][2];
        float mx[ANT];
#pragma unroll
        for (int tt = 0; tt < ANT; ++tt) { float m_ = -1e30f;
#pragma unroll
            for (int st = 0; st < 4; ++st) m_ = fmaxf(m_, fmaxf(fmaxf(s[st][tt][0], s[st][tt][1]), fmaxf(s[st][tt][2], s[st][tt][3])));
            mx[tt] = m_; }
#pragma unroll
        for (int tt = 0; tt < ANT; ++tt) mx[tt] = fmaxf(mx[tt], shx(mx[tt], 16, F.lane));
#pragma unroll
        for (int tt = 0; tt < ANT; ++tt) mx[tt] = fmaxf(mx[tt], shx(mx[tt], 32, F.lane));
#pragma unroll
        for (int tt = 0; tt < ANT; ++tt) {
            const bool need = mx[tt] > mrun[tt] + 8.0f;
            if (__builtin_amdgcn_ballot_w64(need) != 0ull) {
                const float mn = need ? mx[tt] : mrun[tt], alpha = __builtin_amdgcn_exp2f(mrun[tt] - mn);
                mrun[tt] = mn; lrun[tt] *= alpha;
#pragma unroll
                for (int et = 0; et < 8; ++et) o[et][tt] *= alpha;
            }
            const float mref = mrun[tt];
            float ps = 0.f;
#pragma unroll
            for (int st = 0; st < 4; ++st)
#pragma unroll
                for (int j = 0; j < 4; ++j) { const float p = __builtin_amdgcn_exp2f(s[st][tt][j] - mref); s[st][tt][j] = p; ps += p; }
            lrun[tt] += ps;
#pragma unroll
            for (int kk = 0; kk < 2; ++kk) { u32x4 pw; pw.x = pk2(s[2 * kk][tt][0], s[2 * kk][tt][1]); pw.y = pk2(s[2 * kk][tt][2], s[2 * kk][tt][3]);
                pw.z = pk2(s[2 * kk + 1][tt][0], s[2 * kk + 1][tt][1]); pw.w = pk2(s[2 * kk + 1][tt][2], s[2 * kk + 1][tt][3]);
                pf[tt][kk] = __builtin_bit_cast(bf16x8, pw); }
        }
#pragma unroll
        for (int gi = 0; gi < 4; ++gi) {
            const int kk = gi >> 1, eb = (gi & 1) * 4;
            if (gi < 3) { const int kk2 = (gi + 1) >> 1, eb2 = ((gi + 1) & 1) * 4;
#pragma unroll
                for (int e4 = 0; e4 < 4; ++e4) vf[(gi + 1) & 1][e4] = *(const LAS bf16x8*)(Vt + ((eb2 + e4) * 16 + fr) * VP + kk2 * 32 + fq * 8);
            }
            __builtin_amdgcn_sched_barrier(0);
#pragma unroll
            for (int e4 = 0; e4 < 4; ++e4)
#pragma unroll
                for (int tt = 0; tt < ANT; ++tt) o[eb + e4][tt] = mfma16(vf[gi & 1][e4], pf[tt][kk], o[eb + e4][tt]);
            __builtin_amdgcn_sched_barrier(0);
        }
        asm volatile("s_waitcnt vmcnt(0)" ::: "memory");
        __syncthreads();
    }
#undef ATT_DMA
#pragma unroll
    for (int tt = 0; tt < ANT; ++tt) {
        float lt = lrun[tt]; lt += shx(lt, 16, F.lane); lt += shx(lt, 32, F.lane);
        const float inv = 1.0f / lt;
        bf16_t* yd = Y + (size_t)(qrow0 + w * (16 * ANT) + tt * 16 + fr) * 1536 + 512 + h * 128;
#pragma unroll
        for (int et = 0; et < 8; ++et) { u32x2 ow; ow.x = pk2(o[et][tt][0] * inv, o[et][tt][1] * inv); ow.y = pk2(o[et][tt][2] * inv, o[et][tt][3] * inv);
            *(GAS u32x2*)(yd + et * 16 + fq * 4) = ow; }
    }
}

__device__ __forceinline__ void mlstm_chain(const Ctx& F_, int l, int bl, int h, int dir) {
    Ctx F = F_; { int t_ = F_.lane; asm volatile("" : "+v"(t_)); int w_ = F_.wave; asm volatile("" : "+s"(w_)); F.lane = t_; F.wave = w_; F.tid = w_ * 64 + t_; }
    const Params& P = *F.P; unsigned char* ws = F.ws;
    const bf16_t* Z1 = (const bf16_t*)(ws + WS_Z1);
    bf16_t* HO = (bf16_t*)(ws + (dir ? WS_HB : WS_HF));
    LAS bf16_t* Qs = (LAS bf16_t*)F.lds; LAS bf16_t* Ks = Qs + 128 * LP; LAS bf16_t* VTs = Ks + 128 * LP; LAS bf16_t* CTs = VTs + 144 * LP;
    LAS float* fb = (LAS float*)(CTs + 144 * LP);
    LAS float* gI = fb, *gF = fb + 128, *sA = fb + 256, *sM = fb + 384, *sB = fb + 512, *sW = fb + 640, *cw = fb + 768;
    const int t = F.tid, fr = F.lane & 15, fq = F.lane >> 4, w = F.wave;
    for (int i = t; i < 1024; i += NTHREADS) { const int which = i >> 9, j = (i >> 7) & 3, c = i & 127; const int col = which * 512 + h * 128 + c;
        cw[i] = j < 3 ? P.in[8][((size_t)l * 3 + j) * 1024 + col] : P.in[9][(size_t)l * 1024 + col]; }
    for (int i = t; i < 16 * LP; i += NTHREADS) VTs[128 * LP + i] = (i < LP) ? (bf16_t)0x3F80 : (bf16_t)0;
    for (int i = t; i < 144 * LP; i += NTHREADS) CTs[i] = 0;
    const float bgi = P.in[10][l * 16 + dir * 8 + h], bgf = P.in[10][l * 16 + dir * 8 + 4 + h];
    f32x4 cta[9];
#pragma unroll
    for (int et = 0; et < 9; ++et) cta[et] = (f32x4){0.f, 0.f, 0.f, 0.f};
    float mstate = 0.f;
    const int tau_s = t >> 2, cb = (t & 3) * 32;
    u32x4 rq[4], rk[4], rv[4];
#define ML_CHUNK(step) (dir == 0 ? (step) : ((step) < 2 ? 1 - (step) : 19 - (step)))
#define ML_LOAD(step) do { const int R0_ = bl * SEQT + ML_CHUNK(step) * 128; const int r_ = dir ? R0_ + 127 - tau_s : R0_ + tau_s; \
        const bf16_t* qb_ = (const bf16_t*)(ws + WS_H) + (size_t)r_ * 1024 + h * 128 + cb; const bf16_t* vb_ = Z1 + (size_t)r_ * NZ1 + ZV + h * 128 + cb; \
        _Pragma("unroll") for (int i_ = 0; i_ < 4; ++i_) { rq[i_] = *(const GAS u32x4*)(qb_ + i_ * 8); rk[i_] = *(const GAS u32x4*)(qb_ + 512 + i_ * 8); rv[i_] = *(const GAS u32x4*)(vb_ + i_ * 8); } } while (0)
    ML_LOAD(0);
    for (int step = 0; step < 18; ++step) {
        const int c = dir == 0 ? step : (step < 2 ? 1 - step : 19 - step);
        const int R0 = bl * SEQT + c * 128;
        const int seq_lo = c < 2 ? bl * SEQT : bl * SEQT + CTXL, seq_hi = c < 2 ? bl * SEQT + CTXL : (bl + 1) * SEQT;
        __syncthreads();
        if (step > 0) {
#pragma unroll
            for (int et = 0; et < 9; ++et)
#pragma unroll
                for (int j = 0; j < 4; ++j) CTs[(et * 16 + fq * 4 + j) * LP + w * 16 + fr] = f2bf(cta[et][j]);
        }
        {
            const int r = dir ? R0 + 127 - tau_s : R0 + tau_s;
            const bool hp = (r - 1) >= seq_lo, hn = (r + 1) < seq_hi;
            const u32x4 z4 = (u32x4){0u, 0u, 0u, 0u};
#pragma unroll
            for (int i = 0; i < 4; ++i) { *(LAS u32x4*)(Qs + tau_s * LP + cb + i * 8) = rq[i]; *(LAS u32x4*)(Ks + tau_s * LP + cb + i * 8) = rk[i]; }
            (void)hp; (void)hn; (void)z4;
#pragma unroll
            for (int i = 0; i < 4; ++i) { const u32x4 xv = rv[i]; LAS bf16_t* vp = VTs + (cb + i * 8) * LP + (tau_s ^ ((t & 3) << 4));
                vp[0 * LP] = (bf16_t)(xv.x & 0xffff); vp[1 * LP] = (bf16_t)(xv.x >> 16); vp[2 * LP] = (bf16_t)(xv.y & 0xffff); vp[3 * LP] = (bf16_t)(xv.y >> 16);
                vp[4 * LP] = (bf16_t)(xv.z & 0xffff); vp[5 * LP] = (bf16_t)(xv.z >> 16); vp[6 * LP] = (bf16_t)(xv.w & 0xffff); vp[7 * LP] = (bf16_t)(xv.w >> 16); }
            if (t < 128) { const int rg = dir ? R0 + 127 - t : R0 + t; const GAS bf16_t* gp = (const GAS bf16_t*)(Z1 + (size_t)rg * NZ1 + ZMG + dir * 8 + h);
                gI[t] = bf2f(gp[0]) + bgi; gF[t] = logsigmoidf_(bf2f(gp[4]) + bgf); }
        }
        __syncthreads();
        if (step + 1 < 18) ML_LOAD(step + 1);
        float M127, wcdec, mnew;
        {
            const float f0 = gF[2 * F.lane], f1 = gF[2 * F.lane + 1];
            const float ps = f0 + f1; float inc = ps;
#pragma unroll
            for (int o2 = 1; o2 < 64; o2 <<= 1) { const float u = shi(inc, F.lane - o2); if (F.lane >= o2) inc += u; }
            const float b0 = inc - ps + f0, b1 = inc;
            const float a0 = gI[2 * F.lane] - b0, a1 = gI[2 * F.lane + 1] - b1;
            float cmi = fmaxf(a0, a1);
#pragma unroll
            for (int o2 = 1; o2 < 64; o2 <<= 1) { const float u = shi(cmi, F.lane - o2); if (F.lane >= o2) cmi = fmaxf(cmi, u); }
            float cme = shi(cmi, F.lane - 1); if (F.lane == 0) cme = -1e30f;
            const float M0 = fmaxf(mstate, fmaxf(cme, a0)), M1 = fmaxf(mstate, cmi);
            M127 = shi(M1, 63); const float blast = shi(b1, 63);
            sA[2 * F.lane] = a0; sA[2 * F.lane + 1] = a1; sM[2 * F.lane] = M0; sM[2 * F.lane + 1] = M1; sB[2 * F.lane] = b0; sB[2 * F.lane + 1] = b1;
            sW[2 * F.lane] = __expf(a0 - M127); sW[2 * F.lane + 1] = __expf(a1 - M127);
            wcdec = __expf(mstate - M127); mnew = blast + M127;
        }
        asm volatile("s_waitcnt lgkmcnt(0)" ::: "memory");
        const int tau = w * 16 + fr;
        const float Mt = sM[tau];
        bf16x8 qf[4];
#pragma unroll
        for (int kk = 0; kk < 4; ++kk) qf[kk] = *(const LAS bf16x8*)(Qs + tau * LP + kk * 32 + fq * 8);
        bf16x8 pf[4];
#pragma unroll
        for (int kk = 0; kk < 4; ++kk) {
            u32x4 pw = (u32x4){0u, 0u, 0u, 0u};
#pragma unroll
            for (int hh = 0; hh < 2; ++hh) { const int st = 2 * kk + hh;
                if (st <= w) {
                    f32x4 sacc = (f32x4){0.f, 0.f, 0.f, 0.f};
#pragma unroll
                    for (int k2 = 0; k2 < 4; ++k2) { const bf16x8 kf = *(const LAS bf16x8*)(Ks + (st * 16 + fr) * LP + k2 * 32 + fq * 8); sacc = mfma16(kf, qf[k2], sacc); }
                    const f32x4 av = *(const LAS f32x4*)(sA + st * 16 + fq * 4);
                    float p[4];
#pragma unroll
                    for (int j = 0; j < 4; ++j) { const int sg = st * 16 + fq * 4 + j; p[j] = sg <= tau ? sacc[j] * __expf(av[j] - Mt) : 0.f; }
                    if (hh == 0) { pw.x = pk2(p[0], p[1]); pw.y = pk2(p[2], p[3]); } else { pw.z = pk2(p[0], p[1]); pw.w = pk2(p[2], p[3]); }
                }
            }
            pf[kk] = __builtin_bit_cast(bf16x8, pw);
        }
        f32x4 nt[9];
#pragma unroll
        for (int et = 0; et < 9; ++et) nt[et] = (f32x4){0.f, 0.f, 0.f, 0.f};
#pragma unroll
        for (int kk = 0; kk < 4; ++kk)
#pragma unroll
            for (int et = 0; et < 9; ++et) { const bf16x8 cf = *(const LAS bf16x8*)(CTs + (et * 16 + fr) * LP + kk * 32 + fq * 8); nt[et] = mfma16(cf, qf[kk], nt[et]); }
        const float winter = __expf(mstate - Mt);
#pragma unroll
        for (int et = 0; et < 9; ++et) nt[et] *= winter;
#pragma unroll
        for (int kk = 0; kk < 4; ++kk) {
            if (2 * kk <= w) {
#pragma unroll
                for (int et = 0; et < 9; ++et) { const int e = et * 16 + fr; const int swz = ((e >> 5) & 3) << 4; const LAS bf16_t* vrow = VTs + e * LP;
                    const u32x2 a0 = *(const LAS u32x2*)(vrow + ((kk * 32 + fq * 4) ^ swz)), a1 = *(const LAS u32x2*)(vrow + ((kk * 32 + 16 + fq * 4) ^ swz));
                    u32x4 aw; aw.x = a0.x; aw.y = a0.y; aw.z = a1.x; aw.w = a1.y;
                    nt[et] = mfma16(__builtin_bit_cast(bf16x8, aw), pf[kk], nt[et]); }
            }
        }
        {
            const float den = shi(nt[8][0], fr);
            const float mt = sB[tau] + Mt;
            const float dn = fmaxf(fabsf(den), __expf(-mt));
            const float inv = 1.0f / dn;
            const int rr = dir ? R0 + 127 - tau : R0 + tau;
            bf16_t* hd = HO + (size_t)rr * 512 + h * 128;
#pragma unroll
            for (int et = 0; et < 8; ++et) { u32x2 ow; ow.x = pk2(nt[et][0] * inv, nt[et][1] * inv); ow.y = pk2(nt[et][2] * inv, nt[et][3] * inv); *(GAS u32x2*)(hd + et * 16 + fq * 4) = ow; }
        }
#pragma unroll
        for (int et = 0; et < 9; ++et) cta[et] *= wcdec;
#pragma unroll
        for (int kk = 0; kk < 4; ++kk) {
            const int s0 = kk * 32 + fq * 8;
            const f32x4 w0 = *(const LAS f32x4*)(sW + s0), w1 = *(const LAS f32x4*)(sW + s0 + 4);
            const LAS bf16_t* kcol = Ks + s0 * LP + w * 16 + fr;
            u32x4 bw;
            bw.x = pk2(bf2f(kcol[0 * LP]) * w0[0], bf2f(kcol[1 * LP]) * w0[1]); bw.y = pk2(bf2f(kcol[2 * LP]) * w0[2], bf2f(kcol[3 * LP]) * w0[3]);
            bw.z = pk2(bf2f(kcol[4 * LP]) * w1[0], bf2f(kcol[5 * LP]) * w1[1]); bw.w = pk2(bf2f(kcol[6 * LP]) * w1[2], bf2f(kcol[7 * LP]) * w1[3]);
            const bf16x8 bfr = __builtin_bit_cast(bf16x8, bw);
#pragma unroll
            for (int et = 0; et < 9; ++et) { const int e = et * 16 + fr; const int swz = ((e >> 5) & 3) << 4;
                const bf16x8 af = *(const LAS bf16x8*)(VTs + e * LP + (s0 ^ swz)); cta[et] = mfma16(af, bfr, cta[et]); }
        }
        mstate = mnew;
    }
}

__device__ __forceinline__ void phase_mixers(const Ctx& F, int l, int g, int rep) {
    unsigned* counter = (unsigned*)(F.ws + WS_CNT) + (l * 2 + g) * 4 + rep;
    LAS unsigned* slot = (LAS unsigned*)(F.lds + LDS_BYTES - 16);
    constexpr int QB = 2048 / (128 * ANT), CB = 256 / (128 * ANT);
    const int NL = GB * 4 * QB, NA = NL + (l == 0 ? GB * 4 * CB : 0), nch = (l == 0 ? 18 : 16), NS = GB * nch * 4;
    const int total = 64 + NA + NS;
    for (;;) {
        __syncthreads();
        if (F.tid == 0) *slot = __hip_atomic_fetch_add(counter, 1u, __ATOMIC_RELAXED, __HIP_MEMORY_SCOPE_AGENT);
        __syncthreads();
        int it = (int)*slot;
        if (it >= total) break;
        if (it < 64) { REP(7) { __syncthreads(); mlstm_chain(F, l, it >> 3, (it >> 1) & 3, it & 1); } continue; }
        it -= 64;
        if (it < NA) {
            if (it < NL) { const int bl = it / (4 * QB), h = (it / QB) & 3, qb = it % QB; REP(8) { __syncthreads(); attn_unit(F, bl, h, bl * SEQT + CTXL + qb * (128 * ANT), 36); } }
            else { const int ci = it - NL; const int bl = ci / (4 * CB), h = (ci / CB) & 3, cbk = ci % CB; attn_unit(F, bl, h, bl * SEQT + cbk * (128 * ANT), 4); }
            continue;
        }
        it -= NA;
        { const int bl = it / (nch * 4), rem = it % (nch * 4); sgu_unit(F, l, bl, (rem >> 2) + (l == 0 ? 0 : 2), rem & 3); }
    }
}

__global__ void __launch_bounds__(NTHREADS) fwd_megakernel(Params P) {
    extern __shared__ __attribute__((aligned(16))) unsigned char lds_raw[];
    cg::grid_group grid = cg::this_grid();
    Ctx F; F.lds = (LAS unsigned char*)lds_raw; F.wave = __builtin_amdgcn_readfirstlane(threadIdx.x >> 6); F.lane = 0; F.tid = 0; F.P = &P; F.ws = P.ws;
    const int wave0 = F.wave;
    const int G = gridDim.x, c = blockIdx.x;
    volatile LAS unsigned* bst = (volatile LAS unsigned*)(F.lds + LDS_BYTES - 32);
    { int t0_; asm volatile("v_mbcnt_lo_u32_b32 %0, -1, 0\n\tv_mbcnt_hi_u32_b32 %0, -1, %0" : "=v"(t0_));
      if (wave0 == 0 && t0_ < 2) bst[t0_] = 0u;
      __syncthreads();
      if (wave0 == 0 && t0_ == 0) (void)xb_add((unsigned*)(P.ws + WS_BAR) + XB_XCNT(xb_xcc_id()), 1u); }
#define GSYNC() do { REP(3) { int tb_; asm volatile("v_mbcnt_lo_u32_b32 %0, -1, 0\n\tv_mbcnt_hi_u32_b32 %0, -1, %0" : "=v"(tb_)); \
        xcd_barrier((unsigned*)(P.ws + WS_BAR), bst, wave0 == 0 && tb_ == 0); } } while (0)
#define REFRESH() int l = l_; int g = g_; unsigned char* ws = P.ws; do { int t_; asm volatile("v_mbcnt_lo_u32_b32 %0, -1, 0\n\tv_mbcnt_hi_u32_b32 %0, -1, %0" : "=v"(t_)); int w_ = wave0; asm volatile("" : "+s"(w_)); F.lane = t_; F.wave = w_; F.tid = w_ * 64 + t_; \
        asm volatile("" : "+s"(l)); asm volatile("" : "+s"(g)); asm volatile("" : "+s"(ws)); F.ws = ws; } while (0)
#define REFRESH_TID() do { int t_; asm volatile("v_mbcnt_lo_u32_b32 %0, -1, 0\n\tv_mbcnt_hi_u32_b32 %0, -1, %0" : "=v"(t_)); int w_ = wave0; asm volatile("" : "+s"(w_)); F.lane = t_; F.wave = w_; F.tid = w_ * 64 + t_; asm volatile("" : "+s"(l)); asm volatile("" : "+s"(g)); } while (0)
#pragma nounroll
    for (int l_ = 0; l_ < 2; ++l_) {
        REP(4) { const int g_ = 0; REFRESH(); (void)g; phase_prep(F, l); }
        if (l_ == 0) grid.sync();
        { const int g_ = 0; REFRESH(); phase_norm(F, l, g, 0); }
        GSYNC();
#pragma nounroll
        for (int g_ = 0; g_ < NGRP; ++g_) {
            if (l_ == 0) { REFRESH(); (void)l; (void)g; pg8::Order S; S.init(72, NIN, G, c, 0); pg8::Gemm gm{(const bf16_t*)(ws + WS_H), (const bf16_t*)(ws + WS_WIN), 1024, NIN, 1024, 1024};
              EpiIn E{(bf16_t*)(ws + WS_Z1), (bf16_t*)(ws + WS_ZG)}; pg8::gemm_phase(F.lds, gm, S, E, F.tid); }
            else { REFRESH(); (void)l; (void)g; pg8::OrderL1In S; S.base.init(64, NIN, G, c, 1); pg8::Gemm gm{(const bf16_t*)(ws + WS_H), (const bf16_t*)(ws + WS_WIN), 1024, NIN, 1024, 1024};
              EpiIn E{(bf16_t*)(ws + WS_Z1), (bf16_t*)(ws + WS_ZG)}; pg8::gemm_phase(F.lds, gm, S, E, F.tid); }
            GSYNC();
            REP(2) { REFRESH(); (void)g; phase_rowstats(F, l); }
            GSYNC();
            REP(6) {
            { REFRESH(); (void)l; (void)g; pg8::Order S; S.init(72, 768, G, c, 0); pg8::Gemm gm{(const bf16_t*)(ws + WS_Z1) + ZCQ, (const bf16_t*)(ws + WS_WUQ), NZ1, 768, 384, 384};
              EpiQ E{(bf16_t*)(ws + WS_QA), (const float*)(ws + WS_RS), (const float*)(ws + WS_ROPE)}; pg8::gemm_phase(F.lds, gm, S, E, F.tid); }
            { REFRESH(); (void)l; (void)g; pg8::Order S; S.init(72, 512, G, (c + G - (216 % G)) % G, 0);     pg8::Gemm gm{(const bf16_t*)(ws + WS_Z1) + ZCKV, (const bf16_t*)(ws + WS_WUKV), NZ1, 512, 256, 256};
              EpiBf E{(bf16_t*)(ws + WS_KV), 512, (const float*)(ws + WS_RS) + 1}; pg8::gemm_phase(F.lds, gm, S, E, F.tid); }
            { REFRESH(); (void)l; (void)g; pg8::Order S; S.init(2, T, G, (c + G - (104 % G)) % G, 0); pg8::Gemm gm{(const bf16_t*)(ws + WS_WUKV) + (size_t)512 * 256, (const bf16_t*)(ws + WS_Z1) + ZCKV, 256, T, 256, NZ1};
              EpiVT E{(bf16_t*)(ws + WS_KV) + (size_t)T * 512, (const float*)(ws + WS_RS) + 1}; pg8::gemm_phase(F.lds, gm, S, E, F.tid); }
            }
            GSYNC();
            REP(0) { REFRESH(); phase_mixers(F, l, g, rep_); }
            GSYNC();
            REP(2) { REFRESH(); (void)g; phase_mout(F, l); }
            GSYNC();
            REP(5) { REFRESH(); (void)g; const int skip = (l == 1), nM = skip ? 64 : 72; pg8::Order S; S.init(nM, 1024, G, c, skip);
              pg8::Gemm gm{(const bf16_t*)(ws + WS_Y), (const bf16_t*)(ws + WS_WBR), 1536, 1024, 1536, 1536};
              EpiMerge E{(const bf16_t*)(ws + WS_ZG), (bf16_t*)(ws + WS_MB)}; pg8::gemm_phase(F.lds, gm, S, E, F.tid); }
            GSYNC();
            { REFRESH(); pg8::Order S; S.init(64, 1024, G, c, 1);
              pg8::Gemm gm{(const bf16_t*)(ws + WS_MB), (const bf16_t*)(ws + WS_WOUT), 1024, 1024, 1024, 1024};
              EpiRes E{l == 0 ? P.in[0] : P.out, P.out, l == 0 ? P.in[2] : (const float*)(ws + WS_CTXS), (float*)(ws + WS_CTXS), (const float*)(ws + WS_MOD) + (size_t)l * 17 * 6144, 2, g};
              pg8::gemm_phase(F.lds, gm, S, E, F.tid); }
            if (l_ == 0) for (int tk = c; tk < 128; tk += G) { REFRESH(); (void)l;
              const int un = tk >> 2, ks = tk & 3; pg8::OneUnit S{(un >> 2) * 9, un & 3, 1};
              pg8::Gemm gm{(const bf16_t*)(ws + WS_MB) + ks * 256, (const bf16_t*)(ws + WS_WOUT) + ks * 256, 1024, 1024, 256, 1024};
              EpiCtxPart E{(float*)(ws + WS_ZG), ks}; pg8::gemm_phase(F.lds, gm, S, E, F.tid); }
            GSYNC();
            REP(2) { REFRESH(); phase_norm(F, l, g, 1); }
            GSYNC();
            { REFRESH(); (void)g; const int skip = (l == 1); pg8::Order S; S.init(skip ? 64 : 72, 5632, G, c, skip);
              pg8::Gemm gm{(const bf16_t*)(ws + WS_H), (const bf16_t*)(ws + WS_WUP), 1024, 5632, 1024, 1024};
              EpiUpConv E{(bf16_t*)(ws + WS_HID), (bf16_t*)(ws + WS_EDGE), P.in[23] + (size_t)l * 3 * 5632, P.in[24] + (size_t)l * 5632}; pg8::gemm_phase(F.lds, gm, S, E, F.tid); }
            if (l_ == 1 && g_ == 1) { const int l_s = l_, g_s = g_; (void)l_s; (void)g_s; { REFRESH(); (void)l; (void)g; (void)ws; phase_final(F, 0, GB * SEQ, G / 2, G - G / 2); } }
            GSYNC();
            REP(2) { REFRESH(); (void)g; phase_ffedge(F, l); }
            GSYNC();
            { REFRESH(); pg8::Order S; S.init(64, 1024, G, c, 1);
              pg8::Gemm gm{(const bf16_t*)(ws + WS_HID), (const bf16_t*)(ws + WS_WDN), DFF, 1024, DFF, DFF};
              EpiRes E{P.out, P.out, (const float*)(ws + WS_CTXS), (float*)(ws + WS_CTXS), (const float*)(ws + WS_MOD) + (size_t)l * 17 * 6144, 5, g};
              pg8::gemm_phase(F.lds, gm, S, E, F.tid); }
            if (l_ == 0) for (int tk = c; tk < 256; tk += G) { REFRESH(); (void)l;
              const int un = tk >> 3, ks = tk & 7; const int k0 = ks < 6 ? ks * 384 : 2304 + (ks - 6) * 256, kl = ks < 6 ? 384 : 256;
              pg8::OneUnit S{(un >> 2) * 9, un & 3, 1};
              pg8::Gemm gm{(const bf16_t*)(ws + WS_HID) + k0, (const bf16_t*)(ws + WS_WDN) + k0, DFF, 1024, kl, DFF};
              EpiCtxPart E{(float*)(ws + WS_Z1), ks}; pg8::gemm_phase(F.lds, gm, S, E, F.tid); }
            if (g_ == 0) { const int gsave = 1; { int l = l_; int g = gsave; unsigned char* ws = P.ws; (void)ws; REFRESH_TID(); phase_norm(F, l, g, 0); } }
            GSYNC();
            if (l_ == 0) { { REFRESH(); (void)l; phase_ctxsum(F, g); } GSYNC(); }
        }
    }
    { const int l_ = 0, g_ = 0; REFRESH(); (void)l; (void)g; (void)ws; phase_final(F, GB * SEQ, NB * SEQ, 0, G); }
}

extern "C" void kernel_launch(void* const* d_in, const int* in_sizes, int n_in, void* d_out, int out_size, void* d_ws, size_t ws_size, hipStream_t stream) {
    static int grid_blocks = 0;
    if (!grid_blocks) {
        int dev = 0, cus = 0, per_cu = 0;
        hipGetDevice(&dev);
        hipDeviceGetAttribute(&cus, hipDeviceAttributeMultiprocessorCount, dev);
        hipFuncSetAttribute((const void*)fwd_megakernel, hipFuncAttributeMaxDynamicSharedMemorySize, LDS_BYTES);
        hipOccupancyMaxActiveBlocksPerMultiprocessor(&per_cu, (const void*)fwd_megakernel, NTHREADS, LDS_BYTES);
        if (per_cu < 1) per_cu = 1;
        grid_blocks = cus * 1;
        if (ws_size < WS_END) fprintf(stderr, "kernel_launch: workspace too small: %zu < %zu\n", ws_size, (size_t)WS_END);
    }
    Params p{};
    for (int i = 0; i < 27; ++i) p.in[i] = (const float*)d_in[i];
    p.out = (float*)d_out; p.ws = (unsigned char*)d_ws;
    (void)hipMemsetAsync((unsigned char*)d_ws + WS_CNT, 0, 4096 + 16384, stream);
    void* args[] = {&p};
    hipError_t e = hipLaunchCooperativeKernel((const void*)fwd_megakernel, dim3(grid_blocks), dim3(NTHREADS), args, LDS_BYTES, stream);
    if (e != hipSuccess) fprintf(stderr, "cooperative launch failed: %s (grid %d)\n", hipGetErrorString(e), grid_blocks);
}
```

```cpp
#include <hip/hip_runtime.h>
#include <hip/hip_cooperative_groups.h>
#include <cstdio>
namespace cg = cooperative_groups;

#define LAS __attribute__((address_space(3)))
#define GAS __attribute__((address_space(1)))
typedef unsigned short bf16_t;
typedef short bf16x8 __attribute__((ext_vector_type(8)));
typedef float f32x4 __attribute__((ext_vector_type(4)));
typedef float f32x2 __attribute__((ext_vector_type(2)));
typedef unsigned u32x4 __attribute__((ext_vector_type(4)));
typedef unsigned u32x2 __attribute__((ext_vector_type(2)));

constexpr int DM = 1024, NB = 16, SEQ = 2048, CTXL = 256, SEQT = 2304;
constexpr int NGRP = 2, GB = 8, T = GB * SEQT;
constexpr int NZ1 = 3840, NZG = 3072, NIN = 6912;
constexpr int ZQ = 0, ZK = 512, ZV = 1024, ZO = 1536, ZCQ = 2048, ZCKV = 2432, ZKR = 2688, ZMG = 2752, ZU = 2816, ZS = 3328;
constexpr int DFF = 2816;
constexpr int NTHREADS = 512;
constexpr int LDS_BYTES = 155648;
constexpr float EPS = 1e-6f;
constexpr float QSCALE = 0.07216878364870322f * 1.4426950408889634f;

constexpr size_t WS_WIN = 0;
constexpr size_t WS_WUQ = WS_WIN + (size_t)NIN * 1024 * 2;
constexpr size_t WS_WUKV = WS_WUQ + (size_t)768 * 384 * 2;
constexpr size_t WS_WBR = WS_WUKV + (size_t)1024 * 256 * 2;
constexpr size_t WS_WOUT = WS_WBR + (size_t)3 * 1024 * 512 * 2;
constexpr size_t WS_WUP = WS_WOUT + (size_t)1024 * 1024 * 2;
constexpr size_t WS_WDN = WS_WUP + (size_t)5632 * 1024 * 2;
constexpr size_t WS_MOD = WS_WDN + (size_t)1024 * 2816 * 2;
constexpr size_t WS_ROPE = WS_MOD + (size_t)2 * 17 * 6144 * 4;
constexpr size_t WS_CNT = WS_ROPE + (size_t)2048 * 32 * 2 * 4;
constexpr size_t WS_BAR = WS_CNT + 4096;
constexpr size_t WS_CTXS = WS_BAR + 16384;
constexpr size_t WS_RS = WS_CTXS + (size_t)4096 * 1024 * 4;
constexpr size_t WS_H = WS_RS + (size_t)T * 2 * 4;
constexpr size_t WS_Z1 = WS_H + (size_t)T * 1024 * 2;
constexpr size_t WS_ZG = WS_Z1 + (size_t)T * NZ1 * 2;
constexpr size_t WS_QA = WS_ZG + (size_t)T * NZG * 2;
constexpr size_t WS_KV = WS_QA + (size_t)T * 768 * 2;
constexpr size_t WS_KR = WS_KV + (size_t)T * 1024 * 2;
constexpr size_t WS_HF = WS_KR + (size_t)T * 64 * 2;
constexpr size_t WS_HB = WS_HF + (size_t)T * 512 * 2;
constexpr size_t WS_Y = WS_HB + (size_t)T * 512 * 2;
constexpr size_t WS_EDGE = WS_Y + (size_t)T * 1536 * 2;
constexpr size_t WS_END = WS_EDGE + (size_t)72 * 16 * 5632 * 2;
constexpr size_t WS_M32 = WS_Z1;
constexpr size_t WS_MB = WS_Z1 + (size_t)T * 1024 * 4;
constexpr size_t WS_AUP = WS_Z1;
constexpr size_t WS_HID = WS_QA;
static_assert((size_t)T * 2816 * 2 <= (WS_EDGE - WS_QA), "HID alias");
static_assert((size_t)T * 1024 * 6 <= (size_t)T * NZ1 * 2, "M alias");
static_assert(WS_END <= (size_t)512 * 1024 * 1024, "workspace");

struct Params { const float* in[27]; float* out; unsigned char* ws; };
#ifndef PROBE
#define PROBE 0
#endif
#define REP(bit) for (int rep_ = 0; rep_ < (((PROBE) >> (bit)) & 1) + 1; ++rep_)

__device__ __forceinline__ unsigned pk2(float lo, float hi) { unsigned r; asm volatile("v_cvt_pk_bf16_f32 %0, %1, %2" : "=v"(r) : "v"(lo), "v"(hi)); return r; }
__device__ __forceinline__ float bflo(unsigned w) { return __uint_as_float(w << 16); }
__device__ __forceinline__ float bfhi(unsigned w) { return __uint_as_float(w & 0xffff0000u); }
__device__ __forceinline__ float bf2f(bf16_t h) { return __uint_as_float(((unsigned)h) << 16); }
__device__ __forceinline__ bf16_t f2bf(float f) { return (bf16_t)(pk2(f, 0.f) & 0xffffu); }
__device__ __forceinline__ float shx(float v, int o, int lane) { return __int_as_float(__builtin_amdgcn_ds_bpermute((lane ^ o) << 2, __float_as_int(v))); }
__device__ __forceinline__ float shi(float v, int src) { return __int_as_float(__builtin_amdgcn_ds_bpermute(src << 2, __float_as_int(v))); }
__device__ __forceinline__ float wave_sum(float v, int lane) {
    (void)lane;
    v += __int_as_float(__builtin_amdgcn_update_dpp(0, __float_as_int(v), 0xB1, 0xf, 0xf, false));
    v += __int_as_float(__builtin_amdgcn_update_dpp(0, __float_as_int(v), 0x4E, 0xf, 0xf, false));
    v += __int_as_float(__builtin_amdgcn_update_dpp(0, __float_as_int(v), 0x141, 0xf, 0xf, false));
    v += __int_as_float(__builtin_amdgcn_update_dpp(0, __float_as_int(v), 0x140, 0xf, 0xf, false));
    const float s0 = __int_as_float(__builtin_amdgcn_readlane(__float_as_int(v), 0)), s1 = __int_as_float(__builtin_amdgcn_readlane(__float_as_int(v), 16));
    const float s2 = __int_as_float(__builtin_amdgcn_readlane(__float_as_int(v), 32)), s3 = __int_as_float(__builtin_amdgcn_readlane(__float_as_int(v), 48));
    return (s0 + s1) + (s2 + s3);
}
__device__ __forceinline__ float sigmoidf_(float x) { return 1.0f / (1.0f + __expf(-x)); }
__device__ __forceinline__ float siluf_(float x) { return x / (1.0f + __expf(-x)); }
__device__ __forceinline__ float geluf_(float x) {
    const float y2 = -1.5957691216057308f * (x + 0.044715f * x * x * x);
    return x * __builtin_amdgcn_rcpf(1.0f + __expf(y2));
}
__device__ __forceinline__ float logsigmoidf_(float x) { return fminf(x, 0.f) - log1pf(__expf(-fabsf(x))); }
__device__ __forceinline__ f32x4 mfma16(bf16x8 a, bf16x8 b, f32x4 c) { return __builtin_amdgcn_mfma_f32_16x16x32_bf16(a, b, c, 0, 0, 0); }

namespace pg8 {
constexpr int BM = 256, BK = 64, HALF = 128, HTB = HALF * BK * 2, STAGE_BYTES = 8 * HTB, NXCD = 8, WGM = 8;
__device__ __forceinline__ int lds_byte(int r, int c) { const int st = (r >> 4) * 2 + (c >> 5), rr = r & 15, cc = c & 31, ob = rr * 64 + cc * 2; return st * 1024 + (ob ^ (((ob >> 9) & 1) << 5)); }
__device__ __forceinline__ void stage_rc(int b, int& R, int& C) { const int st = b / 1024, sb = b % 1024, swz = sb ^ (((sb >> 9) & 1) << 5); R = (st >> 1) * 16 + swz / 64; C = (st & 1) * 32 + (swz % 64) / 2; }
__device__ __forceinline__ int perm32(int rho) { const int n = rho >> 4, i = rho & 15; return 8 * (i >> 2) + 4 * n + (i & 3); }
struct Unit { int pm, pn; };
struct Gemm { const bf16_t* A; const bf16_t* Bt; int lda, N, K, ldb; };
struct Order {
    int nM, nN, nwg, G, c, skipctx;
    __device__ void init(int nM_, int N, int G_, int c_, int skip) { nM = nM_; nN = N / BM; nwg = nM * nN; G = G_; c = c_; skipctx = skip; }
    __device__ bool next(int i, Unit& u) const {
        const long L = (long)i * G + c; if (L >= nwg) return false;
        int wgid = (int)L; { const int q = nwg / NXCD, r = nwg % NXCD, xcd = wgid % NXCD, off = wgid / NXCD; wgid = (xcd < r ? xcd * (q + 1) : r * (q + 1) + (xcd - r) * q) + off; }
        const int nig = WGM * nN, gid = wgid / nig, fm = gid * WGM, gsz = (nM - fm) < WGM ? (nM - fm) : WGM;
        u.pm = fm + ((wgid % nig) % gsz); u.pn = (wgid % nig) / gsz;
        if (skipctx) u.pm = (u.pm >> 3) * 9 + 1 + (u.pm & 7);
        return true;
    }
};

struct OneUnit {
    int pm, pn, valid;
    __device__ bool next(int i, Unit& u) const { if (i != 0 || !valid) return false; u.pm = pm; u.pn = pn; return true; }
};

struct OrderL1In {
    Order base;
    __device__ bool next(int i, Unit& u) const {
        const long L = (long)i * base.G + base.c;
        if (L < base.nwg) return base.next(i, u);
        const int j = (int)(L - base.nwg); if (j >= 64) return false;
        const int q = j & 7; u.pm = (j >> 3) * 9; u.pn = q < 6 ? q : q + 3; return true;
    }
};

template <class Epi, class Ord>
__device__ __forceinline__ void gemm_phase(LAS unsigned char* lds, const Gemm g, const Ord& S, const Epi& E, int tid_in) {
    int tid = tid_in; asm volatile("" : "+v"(tid));
    const int wid = __builtin_amdgcn_readfirstlane(tid >> 6), lane = tid & 63, wr = wid >> 2, wc = wid & 3, fr = lane & 15, fq = lane >> 4;
    const int K = g.K, nt = K / BK;
    unsigned voffA[2], voffB[2];
#pragma unroll
    for (int i = 0; i < 2; ++i) { int R, C; stage_rc(tid * 16 + i * 8192, R, C); const int Rb = Epi::PERM ? ((R & ~31) + perm32(R & 31)) : R;
        voffA[i] = (unsigned)(R * g.lda + C) * 2u; voffB[i] = (unsigned)(Rb * g.ldb + C) * 2u; }
    const size_t kstep = (size_t)(BK * 2);
    const size_t hstepA = (size_t)HALF * g.lda * 2, hstepB = (size_t)HALF * g.ldb * 2;
    const size_t tstepA = 2 * hstepA, tstepB = 2 * hstepB;
    const unsigned ldsw = (unsigned)wid * 1024u;
    const int aoff = lds_byte(wr * 64 + fr, fq * 8), boff = lds_byte(wc * 32 + fr, fq * 8);
#define PG8_SA(b, h) (((b) * 2 + (h)) * HTB)
#define PG8_SB(b, h) ((4 + (b) * 2 + (h)) * HTB)
#define PG8_STAGE(bufoff, gbase, voff) do { _Pragma("unroll") for (int _i = 0; _i < 2; ++_i) \
        __builtin_amdgcn_global_load_lds((const GAS unsigned*)((const char*)(gbase) + (voff)[_i]), (LAS unsigned*)(lds + (bufoff) + ldsw + _i * 8192), 16, 0, 0); } while (0)
#define PG8_LDA(dst, b, h) do { _Pragma("unroll") for (int m = 0; m < 4; ++m) _Pragma("unroll") for (int k = 0; k < 2; ++k) dst[m][k] = *(const LAS bf16x8*)(lds + PG8_SA(b, h) + aoff + m * 2048 + k * 1024); } while (0)
#define PG8_LDB(dst, b, h) do { _Pragma("unroll") for (int n = 0; n < 2; ++n) _Pragma("unroll") for (int k = 0; k < 2; ++k) dst[n][k] = *(const LAS bf16x8*)(lds + PG8_SB(b, h) + boff + n * 2048 + k * 1024); } while (0)
#define PG8_MMA(ai, bj, At, Bt) do { __builtin_amdgcn_s_setprio(1); _Pragma("unroll") for (int m = 0; m < 4; ++m) _Pragma("unroll") for (int n = 0; n < 2; ++n) _Pragma("unroll") for (int k = 0; k < 2; ++k) \
        acc[ai][bj][m][n] = __builtin_amdgcn_mfma_f32_16x16x32_bf16(Bt[n][k], At[m][k], acc[ai][bj][m][n], 0, 0, 0); __builtin_amdgcn_s_setprio(0); } while (0)
#define PG8_WAIT_V(n) asm volatile("s_waitcnt vmcnt(" #n ")" ::: "memory")
#define PG8_WAIT_L(n) asm volatile("s_waitcnt lgkmcnt(" #n ")" ::: "memory")
#define PG8_BAR __builtin_amdgcn_s_barrier()
#define PG8_SCHED __builtin_amdgcn_sched_barrier(0)
    Unit cur, nxt; int ui = 0;
    if (!S.next(0, cur)) return;
    f32x4 acc[2][2][4][2];
#pragma unroll
    for (int a = 0; a < 2; ++a)
#pragma unroll
        for (int b = 0; b < 2; ++b)
#pragma unroll
            for (int m = 0; m < 4; ++m)
#pragma unroll
                for (int n = 0; n < 2; ++n) acc[a][b][m][n] = (f32x4){0.f, 0.f, 0.f, 0.f};
    bf16x8 At[4][2], B0[2][2], B1[2][2];
    const char* cA = (const char*)g.A + (size_t)cur.pm * tstepA; const char* cB = (const char*)g.Bt + (size_t)cur.pn * tstepB;
    PG8_STAGE(PG8_SB(0, 0), cB, voffB); PG8_STAGE(PG8_SA(0, 0), cA, voffA); PG8_STAGE(PG8_SB(0, 1), cB + hstepB, voffB); PG8_STAGE(PG8_SA(0, 1), cA + hstepA, voffA);
    if (wr == 1) PG8_BAR;
    PG8_WAIT_V(4); PG8_BAR;
    PG8_STAGE(PG8_SB(1, 0), cB + kstep, voffB); PG8_STAGE(PG8_SA(1, 0), cA + kstep, voffA); PG8_STAGE(PG8_SB(1, 1), cB + hstepB + kstep, voffB);
    PG8_WAIT_V(6); PG8_BAR;
    for (;;) {
        const bool has_next = S.next(ui + 1, nxt);
        const char* nA = has_next ? (const char*)g.A + (size_t)nxt.pm * tstepA : cA; const char* nB = has_next ? (const char*)g.Bt + (size_t)nxt.pn * tstepB : cB;
        for (int t = 0; t < nt; t += 2) {
            const bool last = (t == nt - 2);
            const char* a1 = cA + (size_t)(t + 1) * kstep;
            const char* a2 = last ? nA : cA + (size_t)(t + 2) * kstep; const char* b2 = last ? nB : cB + (size_t)(t + 2) * kstep;
            const char* a3 = a2 + kstep; const char* b3 = b2 + kstep;
            if constexpr (Epi::RESCALE) { if (t == 8 || t == 16) { int ln_; asm volatile("v_mbcnt_lo_u32_b32 %0, -1, 0\n\tv_mbcnt_hi_u32_b32 %0, -1, %0" : "=v"(ln_)); E.rescale(acc, cur, t >> 4, wr, wc, ln_ & 15, ln_ >> 4); } }
            PG8_LDB(B0, 0, 0); PG8_SCHED; PG8_LDA(At, 0, 0); PG8_STAGE(PG8_SA(1, 1), a1 + hstepA, voffA);
            PG8_WAIT_L(8); PG8_BAR; PG8_WAIT_L(0); PG8_MMA(0, 0, At, B0); PG8_BAR; PG8_SCHED;
            PG8_LDB(B1, 0, 1); PG8_STAGE(PG8_SB(0, 0), b2, voffB);
            PG8_BAR; PG8_WAIT_L(0); PG8_MMA(0, 1, At, B1); PG8_BAR;
            PG8_LDA(At, 0, 1); PG8_STAGE(PG8_SA(0, 0), a2, voffA);
            PG8_BAR; PG8_WAIT_L(0); PG8_MMA(1, 0, At, B0); PG8_BAR; PG8_SCHED;
            PG8_STAGE(PG8_SB(0, 1), b2 + hstepB, voffB);
            PG8_WAIT_V(6); PG8_BAR; PG8_MMA(1, 1, At, B1); PG8_BAR;
            PG8_LDB(B0, 1, 0); PG8_SCHED; PG8_LDA(At, 1, 0); PG8_STAGE(PG8_SA(0, 1), a2 + hstepA, voffA);
            PG8_WAIT_L(8); PG8_BAR; PG8_WAIT_L(0); PG8_MMA(0, 0, At, B0); PG8_BAR; PG8_SCHED;
            PG8_LDB(B1, 1, 1); PG8_STAGE(PG8_SB(1, 0), b3, voffB);
            PG8_BAR; PG8_WAIT_L(0); PG8_MMA(0, 1, At, B1); PG8_BAR;
            PG8_LDA(At, 1, 1); PG8_STAGE(PG8_SA(1, 0), a3, voffA);
            PG8_BAR; PG8_WAIT_L(0); PG8_MMA(1, 0, At, B0); PG8_BAR; PG8_SCHED;
            PG8_STAGE(PG8_SB(1, 1), b3 + hstepB, voffB);
            PG8_WAIT_V(6); PG8_BAR; PG8_MMA(1, 1, At, B1); PG8_BAR;
        }
        { int ln_; asm volatile("v_mbcnt_lo_u32_b32 %0, -1, 0\n\tv_mbcnt_hi_u32_b32 %0, -1, %0" : "=v"(ln_)); E(acc, cur, wr, wc, ln_ & 15, ln_ >> 4); }
        if (!has_next) break;
#pragma unroll
        for (int a = 0; a < 2; ++a)
#pragma unroll
            for (int b = 0; b < 2; ++b)
#pragma unroll
                for (int m = 0; m < 4; ++m)
#pragma unroll
                    for (int n = 0; n < 2; ++n) acc[a][b][m][n] = (f32x4){0.f, 0.f, 0.f, 0.f};
        cur = nxt; cA = nA; cB = nB; ++ui;
    }
    PG8_WAIT_V(0);
    if (wr == 0) PG8_BAR;
    PG8_BAR;
#undef PG8_SA
#undef PG8_SB
#undef PG8_STAGE
#undef PG8_LDA
#undef PG8_LDB
#undef PG8_MMA
#undef PG8_WAIT_V
#undef PG8_WAIT_L
#undef PG8_BAR
#undef PG8_SCHED
}
}

typedef const f32x4 (&AccRef)[2][2][4][2];

struct EpiIn {
    static constexpr bool PERM = true, RESCALE = false;
    bf16_t* Z1; bf16_t* ZG;
    __device__ __forceinline__ void operator()(AccRef acc, const pg8::Unit& u, int wr, int wc, int fr, int fq) const {
        asm volatile("" : "+v"(fr), "+v"(fq));
        bf16_t* base; int ld;
        if (u.pn < 15) { base = Z1 + u.pn * 256; ld = NZ1; } else { base = ZG + (u.pn - 15) * 256; ld = NZG; }
        const int row0 = u.pm * 256 + wr * 64 + fr, col0 = wc * 32 + 8 * fq;
#pragma unroll
        for (int ai = 0; ai < 2; ++ai)
#pragma unroll
            for (int m = 0; m < 4; ++m) { bf16_t* rowp = base + (size_t)(row0 + ai * 128 + m * 16) * ld + col0;
#pragma unroll
                for (int bj = 0; bj < 2; ++bj) { const f32x4 v0 = acc[ai][bj][m][0], v1 = acc[ai][bj][m][1];
                    u32x4 w; w.x = pk2(v0[0], v0[1]); w.y = pk2(v0[2], v0[3]); w.z = pk2(v1[0], v1[1]); w.w = pk2(v1[2], v1[3]);
                    *(GAS u32x4*)(rowp + bj * 128) = w; } }
    }
};
struct EpiBf {
    static constexpr bool PERM = true, RESCALE = false;
    bf16_t* O; int ld; const float* rs;
    __device__ __forceinline__ void operator()(AccRef acc, const pg8::Unit& u, int wr, int wc, int fr, int fq) const {
        asm volatile("" : "+v"(fr), "+v"(fq));
        const int row0 = u.pm * 256 + wr * 64 + fr, col0 = u.pn * 256 + wc * 32 + 8 * fq;
#pragma unroll
        for (int ai = 0; ai < 2; ++ai)
#pragma unroll
            for (int m = 0; m < 4; ++m) { const int row = row0 + ai * 128 + m * 16; bf16_t* rowp = O + (size_t)row * ld + col0;
                const float s = rs ? ((const GAS float*)rs)[row * 2] : 1.0f;
#pragma unroll
                for (int bj = 0; bj < 2; ++bj) { const f32x4 v0 = acc[ai][bj][m][0] * s, v1 = acc[ai][bj][m][1] * s;
                    u32x4 w; w.x = pk2(v0[0], v0[1]); w.y = pk2(v0[2], v0[3]); w.z = pk2(v1[0], v1[1]); w.w = pk2(v1[2], v1[3]);
                    *(GAS u32x4*)(rowp + bj * 128) = w; } }
    }
};
struct EpiVT {
    static constexpr bool PERM = true, RESCALE = false;
    bf16_t* O; const float* rs;
    __device__ __forceinline__ void operator()(AccRef acc, const pg8::Unit& u, int wr, int wc, int fr, int fq) const {
        asm volatile("" : "+v"(fr), "+v"(fq));
        const int bl = u.pn / 9, p0 = (u.pn % 9) * 256;
        const int f0 = u.pm * 256 + wr * 64 + fr;
#pragma unroll
        for (int bj = 0; bj < 2; ++bj)
#pragma unroll
            for (int n = 0; n < 2; ++n) { const int cl = bj * 128 + wc * 32 + 8 * fq + 4 * n;
                const GAS float* rp = (const GAS float*)(rs + (size_t)(u.pn * 256 + cl) * 2);
                const float s0 = rp[0], s1 = rp[2], s2 = rp[4], s3 = rp[6];
                const int pos = (cl & ~31) + ((cl >> 2) & 3) * 8 + ((cl >> 4) & 1) * 4;
#pragma unroll
                for (int ai = 0; ai < 2; ++ai)
#pragma unroll
                    for (int m = 0; m < 4; ++m) { const int f = f0 + ai * 128 + m * 16; const int hh = f >> 7, e = f & 127;
                        const f32x4 v = acc[ai][bj][m][n];
                        u32x2 w; w.x = pk2(v[0] * s0, v[1] * s1); w.y = pk2(v[2] * s2, v[3] * s3);
                        *(GAS u32x2*)(O + ((size_t)((bl * 4 + hh) * 128 + e)) * SEQT + p0 + pos) = w; }
                asm volatile("" ::: "memory"); }
    }
};
struct EpiQ {
    static constexpr bool PERM = false, RESCALE = false;
    bf16_t* O; const float* rs; const float* rope;
    __device__ __forceinline__ void operator()(AccRef acc, const pg8::Unit& u, int wr, int wc, int fr, int fq) const {
        asm volatile("" : "+v"(fr), "+v"(fq));
        const int row0 = u.pm * 256 + wr * 64 + fr;
        const bool lat = (u.pm % 9) != 0;
        const int posb = ((u.pm % 9) - 1) * 256 + wr * 64 + fr;
#pragma unroll
        for (int ai = 0; ai < 2; ++ai)
#pragma unroll
            for (int m = 0; m < 4; ++m) { const int row = row0 + ai * 128 + m * 16; const int pos = posb + ai * 128 + m * 16;
                const float s = ((const GAS float*)rs)[row * 2] * QSCALE;
#pragma unroll
                for (int bj = 0; bj < 2; ++bj)
#pragma unroll
                    for (int n = 0; n < 2; ++n) { const int c0 = u.pn * 256 + bj * 128 + wc * 32 + 16 * n + 4 * fq; const int within = c0 % 192;
                        f32x4 v0 = acc[ai][bj][m][n] * s;
                        if (lat && within >= 128) { const int i0 = (within - 128) >> 1; const f32x4 r0 = *(const GAS f32x4*)(rope + ((size_t)pos * 32 + i0) * 2);
                            float a, b;
                            a = v0[0] * r0[0] - v0[1] * r0[1]; b = v0[0] * r0[1] + v0[1] * r0[0]; v0[0] = a; v0[1] = b;
                            a = v0[2] * r0[2] - v0[3] * r0[3]; b = v0[2] * r0[3] + v0[3] * r0[2]; v0[2] = a; v0[3] = b; }
                        u32x2 w; w.x = pk2(v0[0], v0[1]); w.y = pk2(v0[2], v0[3]);
                        *(GAS u32x2*)(O + (size_t)row * 768 + c0) = w; }
                asm volatile("" ::: "memory"); }
    }
};
struct EpiMerge {
    static constexpr bool PERM = false, RESCALE = true;
    const bf16_t* ZG; bf16_t* MB;
    __device__ __forceinline__ void rescale(f32x4 (&acc)[2][2][4][2], const pg8::Unit& u, int seg, int wr, int wc, int fr, int fq) const {
        const int row0 = u.pm * 256 + wr * 64 + fr, col0 = u.pn * 256 + wc * 32 + 4 * fq;
#pragma unroll
        for (int ai = 0; ai < 2; ++ai)
#pragma unroll
            for (int m = 0; m < 4; ++m) { const bf16_t* zr = ZG + (size_t)(row0 + ai * 128 + m * 16) * NZG + seg * 1024 + col0;
#pragma unroll
                for (int bj = 0; bj < 2; ++bj)
#pragma unroll
                    for (int n = 0; n < 2; ++n) { const u32x2 ga = *(const GAS u32x2*)(zr + bj * 128 + n * 16), gb = *(const GAS u32x2*)(zr + 1024 + bj * 128 + n * 16);
                        f32x4 r;
                        r[0] = (1.0f + __expf(-bflo(gb.x))) * __builtin_amdgcn_rcpf(1.0f + __expf(-bflo(ga.x)));
                        r[1] = (1.0f + __expf(-bfhi(gb.x))) * __builtin_amdgcn_rcpf(1.0f + __expf(-bfhi(ga.x)));
                        r[2] = (1.0f + __expf(-bflo(gb.y))) * __builtin_amdgcn_rcpf(1.0f + __expf(-bflo(ga.y)));
                        r[3] = (1.0f + __expf(-bfhi(gb.y))) * __builtin_amdgcn_rcpf(1.0f + __expf(-bfhi(ga.y)));
                        acc[ai][bj][m][n] *= r; }
                asm volatile("" ::: "memory"); }
    }
    __device__ __forceinline__ void operator()(AccRef acc, const pg8::Unit& u, int wr, int wc, int fr, int fq) const {
        asm volatile("" : "+v"(fr), "+v"(fq));
        const int row0 = u.pm * 256 + wr * 64 + fr, col0 = u.pn * 256 + wc * 32 + 4 * fq;
#pragma unroll
        for (int ai = 0; ai < 2; ++ai)
#pragma unroll
            for (int m = 0; m < 4; ++m) { const int row = row0 + ai * 128 + m * 16;
#pragma unroll
                for (int bj = 0; bj < 2; ++bj)
#pragma unroll
                    for (int n = 0; n < 2; ++n) { const int c = col0 + bj * 128 + n * 16;
                        const u32x2 gw = *(const GAS u32x2*)(ZG + (size_t)row * NZG + 2 * 1024 + c);
                        f32x4 gt; gt[0] = sigmoidf_(bflo(gw.x)); gt[1] = sigmoidf_(bfhi(gw.x)); gt[2] = sigmoidf_(bflo(gw.y)); gt[3] = sigmoidf_(bfhi(gw.y));
                        const f32x4 v = gt * acc[ai][bj][m][n];
                        u32x2 w; w.x = pk2(v[0], v[1]); w.y = pk2(v[2], v[3]); *(GAS u32x2*)(MB + (size_t)row * 1024 + c) = w; } }
    }
};
__device__ __forceinline__ float dpp_ror1(float v) { return __int_as_float(__builtin_amdgcn_update_dpp(0, __float_as_int(v), 0x121, 0xf, 0xf, false)); }
__device__ __forceinline__ float dpp_ror15(float v) { return __int_as_float(__builtin_amdgcn_update_dpp(0, __float_as_int(v), 0x12f, 0xf, 0xf, false)); }
struct EpiUpConv {
    static constexpr bool PERM = true, RESCALE = false;
    bf16_t* HID; bf16_t* EDGE; const float* wc; const float* bc;
    __device__ __forceinline__ void operator()(AccRef acc, const pg8::Unit& u, int wr, int wc_, int fr, int fq) const {
        asm volatile("" : "+v"(fr), "+v"(fq));
        const int ch0 = u.pn * 128 + wc_ * 32 + 8 * fq;
#pragma unroll
        for (int n = 0; n < 2; ++n) {
            int fq2 = fq; asm volatile("" : "+v"(fq2));
            const int ch = u.pn * 128 + wc_ * 32 + 8 * fq2 + 4 * n; (void)ch0;
            const f32x4 wg0 = *(const GAS f32x4*)(wc + ch), wg1 = *(const GAS f32x4*)(wc + 5632 + ch), wg2 = *(const GAS f32x4*)(wc + 2 * 5632 + ch), bg = *(const GAS f32x4*)(bc + ch);
            const f32x4 wv0 = *(const GAS f32x4*)(wc + DFF + ch), wv1 = *(const GAS f32x4*)(wc + 5632 + DFF + ch), wv2 = *(const GAS f32x4*)(wc + 2 * 5632 + DFF + ch), bv = *(const GAS f32x4*)(bc + DFF + ch);
#pragma unroll
            for (int ai = 0; ai < 2; ++ai) {
                const int blk = ai * 2 + wr; const int rowb = u.pm * 256 + blk * 64;
                bf16_t* eg = EDGE + ((size_t)(u.pm * 4 + blk) * 4) * 5632 + ch;
                if (fr < 2) { const f32x4 g = acc[ai][0][0][n], v = acc[ai][1][0][n]; u32x2 a, b; a.x = pk2(g[0], g[1]); a.y = pk2(g[2], g[3]); b.x = pk2(v[0], v[1]); b.y = pk2(v[2], v[3]);
                    *(GAS u32x2*)(eg + (size_t)fr * 5632) = a; *(GAS u32x2*)(eg + (size_t)fr * 5632 + DFF) = b; }
                if (fr >= 14) { const f32x4 g = acc[ai][0][3][n], v = acc[ai][1][3][n]; u32x2 a, b; a.x = pk2(g[0], g[1]); a.y = pk2(g[2], g[3]); b.x = pk2(v[0], v[1]); b.y = pk2(v[2], v[3]);
                    *(GAS u32x2*)(eg + (size_t)(fr - 12) * 5632) = a; *(GAS u32x2*)(eg + (size_t)(fr - 12) * 5632 + DFF) = b; }
#pragma unroll
                for (int m = 0; m < 4; ++m) {
                    f32x4 o;
#pragma unroll
                    for (int j = 0; j < 4; ++j) {
                        const float gc = acc[ai][0][m][n][j], vc = acc[ai][1][m][n][j];
                        const float gpa = dpp_ror1(gc), gpb = dpp_ror1(acc[ai][0][m > 0 ? m - 1 : 0][n][j]), gna = dpp_ror15(gc), gnb = dpp_ror15(acc[ai][0][m < 3 ? m + 1 : 3][n][j]);
                        const float vpa = dpp_ror1(vc), vpb = dpp_ror1(acc[ai][1][m > 0 ? m - 1 : 0][n][j]), vna = dpp_ror15(vc), vnb = dpp_ror15(acc[ai][1][m < 3 ? m + 1 : 3][n][j]);
                        const float gp = fr == 0 ? gpb : gpa, gn = fr == 15 ? gnb : gna, vp = fr == 0 ? vpb : vpa, vn = fr == 15 ? vnb : vna;
                        const float cg = bg[j] + wg0[j] * gp + wg1[j] * gc + wg2[j] * gn;
                        const float cv = bv[j] + wv0[j] * vp + wv1[j] * vc + wv2[j] * vn;
                        o[j] = siluf_(cg) * cv;
                    }
                    const bool seam = (m == 0 && fr == 0) || (m == 3 && fr == 15);
                    if (!seam) { u32x2 w; w.x = pk2(o[0], o[1]); w.y = pk2(o[2], o[3]); *(GAS u32x2*)(HID + (size_t)(rowb + m * 16 + fr) * DFF + ch) = w; }
                }
            }
        }
    }
};
struct EpiCtxPart {
    static constexpr bool PERM = false, RESCALE = false;
    float* pb; int ks;
    __device__ __forceinline__ void operator()(AccRef acc, const pg8::Unit& u, int wr, int wc, int fr, int fq) const {
        asm volatile("" : "+v"(fr), "+v"(fq));
        const int bl = u.pm / 9;
        float* dst = pb + ((size_t)ks * (GB * CTXL) + bl * CTXL) * DM;
        const int r0 = wr * 64 + fr, col0 = u.pn * 256 + wc * 32 + 4 * fq;
#pragma unroll
        for (int ai = 0; ai < 2; ++ai)
#pragma unroll
            for (int m = 0; m < 4; ++m)
#pragma unroll
                for (int bj = 0; bj < 2; ++bj)
#pragma unroll
                    for (int n = 0; n < 2; ++n) *(GAS f32x4*)(dst + (size_t)(r0 + ai * 128 + m * 16) * DM + col0 + bj * 128 + n * 16) = acc[ai][bj][m][n];
    }
};
struct EpiRes {
    static constexpr bool PERM = false, RESCALE = false;
    const float* xsrc; float* xdst; const float* csrc; float* cdst; const float* mod; int mi; int grp;
    __device__ __forceinline__ void operator()(AccRef acc, const pg8::Unit& u, int wr, int wc, int fr, int fq) const {
        asm volatile("" : "+v"(fr), "+v"(fq));
        const int bl = u.pm / 9, j = u.pm % 9, b = grp * GB + bl;
        const float* src; float* dst; int mrow;
        if (j == 0) { src = csrc + (size_t)b * CTXL * DM; dst = cdst + (size_t)b * CTXL * DM; mrow = 16; }
        else { const size_t o = ((size_t)b * SEQ + (j - 1) * 256) * DM; src = xsrc + o; dst = xdst + o; mrow = b; }
        const float* mv = mod + mrow * 6144 + mi * 1024;
        const int r0 = wr * 64 + fr, col0 = u.pn * 256 + wc * 32 + 4 * fq;
        f32x4 mg[2][2];
#pragma unroll
        for (int bj = 0; bj < 2; ++bj)
#pragma unroll
            for (int n = 0; n < 2; ++n) mg[bj][n] = *(const GAS f32x4*)(mv + col0 + bj * 128 + n * 16);
#pragma unroll
        for (int ai = 0; ai < 2; ++ai)
#pragma unroll
            for (int m = 0; m < 4; ++m) { const size_t ro = (size_t)(r0 + ai * 128 + m * 16) * DM + col0;
#pragma unroll
                for (int bj = 0; bj < 2; ++bj)
#pragma unroll
                    for (int n = 0; n < 2; ++n) { const f32x4 xo = *(const GAS f32x4*)(src + ro + bj * 128 + n * 16);
                        *(GAS f32x4*)(dst + ro + bj * 128 + n * 16) = xo + mg[bj][n] * acc[ai][bj][m][n]; } }
    }
};

#define XB_TMO      128
#define XB_XCNT(j)  (256  + 64 * (j))
#define XB_XSUB(j)  (1280 + 64 * (j))
#define XB_XGEN(j)  (2304 + 64 * (j))
#define XB_TOP      3328
#define XB_TOPGEN   3392
#define XCD_BAR_WORDS 3456
#define XB_SPIN_CAP (1u << 20)
__device__ __forceinline__ unsigned xb_ld(unsigned* p)              { return __hip_atomic_load(p, __ATOMIC_RELAXED, __HIP_MEMORY_SCOPE_AGENT); }
__device__ __forceinline__ unsigned xb_add(unsigned* p, unsigned v) { return __hip_atomic_fetch_add(p, v, __ATOMIC_RELAXED, __HIP_MEMORY_SCOPE_AGENT); }
__device__ __forceinline__ unsigned xb_xcc_id() { return (unsigned)__builtin_amdgcn_s_getreg((3 << 11) | 20) & 0xFu; }
#define XB_SPIN(cond, bar) do { unsigned _sp = 0; while (cond) { __builtin_amdgcn_s_sleep(1); \
    if ((++_sp & 255u) == 0u) { if (xb_ld(&(bar)[XB_TMO])) break; if (_sp > XB_SPIN_CAP) { xb_add(&(bar)[XB_TMO], 1u); break; } } } } while (0)
__device__ __forceinline__ void xcd_barrier_complete(unsigned* bar, unsigned x, unsigned& nloc, unsigned& nx) {
    const unsigned G = gridDim.x;
    unsigned sum, cnt, mine, sp = 0u;
    for (;;) {
        sum = 0u; cnt = 0u; mine = 0u;
#pragma unroll
        for (unsigned j = 0; j < 16; ++j) { const unsigned c = xb_ld(&bar[XB_XCNT(j)]); sum += c; cnt += (c > 0u) ? 1u : 0u; mine = (j == x) ? c : mine; }
        if (sum == G) break;
        __builtin_amdgcn_s_sleep(1);
        if ((++sp & 255u) == 0u) { if (xb_ld(&bar[XB_TMO])) break; if (sp > XB_SPIN_CAP) { xb_add(&bar[XB_TMO], 1u); break; } }
    }
    nloc = mine > 0u ? mine : 1u; nx = cnt > 0u ? cnt : 1u;
}
__device__ __forceinline__ void xcd_barrier(unsigned* bar, volatile LAS unsigned* st, bool leader) {
    asm volatile("s_waitcnt vmcnt(0)" ::: "memory");
    __syncthreads();
    if (leader) {
        __builtin_amdgcn_s_waitcnt(0);
        const unsigned x = xb_xcc_id();
        unsigned nloc = st[0], nx = st[1];
        if (nloc == 0u) { xcd_barrier_complete(bar, x, nloc, nx); st[0] = nloc; st[1] = nx; }
        const unsigned old = xb_add(&bar[XB_XSUB(x)], 1u);
        const unsigned gen = old / nloc;
        if (old + 1u == (gen + 1u) * nloc) {
            __builtin_amdgcn_fence(__ATOMIC_RELEASE, "agent");
            asm volatile("s_waitcnt vmcnt(0)" ::: "memory");
            const unsigned og = xb_add(&bar[XB_TOP], 1u);
            const unsigned tg = og / nx;
            if (og + 1u == (tg + 1u) * nx) xb_add(&bar[XB_TOPGEN], 1u);
            else XB_SPIN(xb_ld(&bar[XB_TOPGEN]) == tg, bar);
            __builtin_amdgcn_fence(__ATOMIC_ACQUIRE, "agent");
            xb_add(&bar[XB_XGEN(x)], 1u);
            asm volatile("s_waitcnt vmcnt(0)" ::: "memory");
        } else {
            XB_SPIN(xb_ld(&bar[XB_XGEN(x)]) == gen, bar);
            __builtin_amdgcn_fence(__ATOMIC_ACQUIRE, "agent");
            asm volatile("s_waitcnt vmcnt(0)" ::: "memory");
        }
    }
    __syncthreads();
}

struct Ctx {
    LAS unsigned char* lds; int tid, lane, wave;
    const Params* P; unsigned char* ws;
};

__device__ __forceinline__ int inmap(int n) {
    if (n < 2048) return n;
    if (n < 2432) return 2064 + (n - 2048);
    if (n < 2688) return 2448 + (n - 2432);
    if (n < 2752) return 2704 + (n - 2688);
    if (n < 2768) return 2048 + (n - 2752);
    if (n < 2816) return -1;
    if (n < 3328) return 2768 + (n - 2816);
    if (n < 3840) return 3280 + (n - 3328);
    return 3792 + (n - 3840);
}

__device__ __forceinline__ void wprep_tile(const Ctx& F, const float* W, int ldw, int K, bf16_t* Bt, int n0, int k0, int isin, const float* kscale, int ldb = 0) {
    if (ldb == 0) ldb = K;
    LAS float* tile = (LAS float*)F.lds;
    const int t = F.tid;
    const int nn = t & 63, kb = t >> 6;
    const int nq = n0 + nn;
    const int sc = isin == 1 ? inmap(nq) : isin == 2 ? (((nq & 511) >> 7) * 256 + (nq >> 9) * 128 + (nq & 127)) : isin == 3 ? (((nq >> 7) & 1) * DFF + (nq >> 8) * 128 + (nq & 127)) : nq;
#pragma unroll
    for (int i = 0; i < 8; ++i) { const int kk = i * 8 + kb; float v = sc >= 0 ? W[(size_t)(k0 + kk) * ldw + sc] : 0.f; if (kscale) v *= kscale[k0 + kk]; tile[kk * 65 + nn] = v; }
    __syncthreads();
    const int n = t >> 3, c = t & 7;
    const LAS float* s = tile + (8 * c) * 65 + n;
    u32x4 o; o.x = pk2(s[0], s[65]); o.y = pk2(s[130], s[195]); o.z = pk2(s[260], s[325]); o.w = pk2(s[390], s[455]);
    *(GAS u32x4*)(Bt + (size_t)(n0 + n) * ldb + k0 + 8 * c) = o;
}

__device__ __forceinline__ void phase_prep(const Ctx& F, int l, int lo, int hi, int wlo, int wcnt) {
    const Params& P = *F.P; unsigned char* ws = F.ws;
    const int NWT = 1728 + 72 + 64 + 384 + 256 + 1408 + 704;
    const int total = NWT + (l == 0 ? 192 + 128 : 0);
    if (hi < 0 || hi > total) hi = total;
    if ((int)blockIdx.x < wlo || (int)blockIdx.x >= wlo + wcnt) return;
    for (int it0 = lo + ((int)blockIdx.x - wlo); it0 < hi; it0 += wcnt) {
        __syncthreads();
        int it = it0;
        if (it < NWT) {
            if (it < 1728) { wprep_tile(F, P.in[7] + (size_t)l * 1024 * 6864, 6864, 1024, (bf16_t*)(ws + WS_WIN), (it / 16) * 64, (it % 16) * 64, 1, nullptr); continue; } it -= 1728;
            if (it < 72) { wprep_tile(F, P.in[13] + (size_t)l * 384 * 768, 768, 384, (bf16_t*)(ws + WS_WUQ), (it / 6) * 64, (it % 6) * 64, 0, P.in[12] + l * 384); continue; } it -= 72;
            if (it < 64) { wprep_tile(F, P.in[15] + (size_t)l * 256 * 1024, 1024, 256, (bf16_t*)(ws + WS_WUKV), (it / 4) * 64, (it % 4) * 64, 2, P.in[14] + l * 256); continue; } it -= 64;
            if (it < 384) { const int gb = it / 128, r = it % 128; wprep_tile(F, P.in[19] + ((size_t)l * 3 + gb) * 512 * 1024, 1024, 512, (bf16_t*)(ws + WS_WBR) + (size_t)gb * 512, (r / 8) * 64, (r % 8) * 64, 0, nullptr, 1536); continue; } it -= 384;
            if (it < 256) { wprep_tile(F, P.in[20] + (size_t)l * 1024 * 1024, 1024, 1024, (bf16_t*)(ws + WS_WOUT), (it / 16) * 64, (it % 16) * 64, 0, nullptr); continue; } it -= 256;
            if (it < 1408) { wprep_tile(F, P.in[22] + (size_t)l * 1024 * 5632, 5632, 1024, (bf16_t*)(ws + WS_WUP), (it / 16) * 64, (it % 16) * 64, 3, nullptr); continue; } it -= 1408;
            wprep_tile(F, P.in[25] + (size_t)l * 2816 * 1024, 1024, 2816, (bf16_t*)(ws + WS_WDN), (it / 44) * 64, (it % 44) * 64, 0, nullptr); continue;
        }
        it -= NWT;
        if (it < 192) {
            const int l2 = it / 96, nb = it % 96;
            LAS float* cond = (LAS float*)F.lds; LAS float* red = cond + 17 * 1024;
            for (int i = F.tid; i < 17 * 1024; i += NTHREADS) { const int r = i >> 10, k = i & 1023; const float cv = r < 16 ? P.in[1][r * 1024 + k] : P.in[3][k]; cond[i] = siluf_(cv); }
            __syncthreads();
            const int cc = F.tid & 63, ks = F.tid >> 6; const int col = nb * 64 + cc;
            const float* wa = P.in[4] + (size_t)l2 * 1024 * 6144 + col;
            float a[17];
#pragma unroll
            for (int r = 0; r < 17; ++r) a[r] = 0.f;
            for (int k = ks * 128; k < ks * 128 + 128; ++k) { const float w = wa[(size_t)k * 6144];
#pragma unroll
                for (int r = 0; r < 17; ++r) a[r] += cond[r * 1024 + k] * w; }
#pragma unroll
            for (int r = 0; r < 17; ++r) red[(ks * 17 + r) * 64 + cc] = a[r];
            __syncthreads();
            for (int i = F.tid; i < 17 * 64; i += NTHREADS) { const int r = i >> 6, c2 = i & 63; float s = P.in[5][l2 * 6144 + nb * 64 + c2];
#pragma unroll
                for (int q = 0; q < 8; ++q) s += red[(q * 17 + r) * 64 + c2];
                ((float*)(ws + WS_MOD))[((size_t)l2 * 17 + r) * 6144 + nb * 64 + c2] = s; }
            continue;
        }
        it -= 192;
        {
            const int e = it * NTHREADS + F.tid; const int pos = e >> 5, i = e & 31;
            const float inv = exp2f(-(float)(i & 15) * (13.287712379549449f / 16.0f));
            const float ang = (float)(i < 16 ? (pos >> 6) : (pos & 63)) * inv;
            f32x2 cs; cs.x = cosf(ang); cs.y = sinf(ang);
            ((GAS f32x2*)(ws + WS_ROPE))[e] = cs;
        }
    }
}

__device__ __forceinline__ void phase_norm(const Ctx& F, int l, int g, int which) {
    const Params& P = *F.P; unsigned char* ws = F.ws;
    const float* gvec = (which ? P.in[21] : P.in[6]) + l * 1024;
    const float* mod = (const float*)(ws + WS_MOD) + (size_t)l * 17 * 6144;
    const float* xin = (l == 0 && !which) ? P.in[0] : P.out;
    const float* cin = (l == 0 && !which) ? P.in[2] : (const float*)(ws + WS_CTXS);
    bf16_t* H = (bf16_t*)(ws + WS_H);
    for (int r = blockIdx.x * 8 + F.wave; r < T; r += gridDim.x * 8) {
        const int bl = r / SEQT, p = r % SEQT, b = g * GB + bl;
        const float* src; int mrow;
        if (p < CTXL) { if (which && l == 1) continue; src = cin + ((size_t)b * CTXL + p) * DM; mrow = 16; }
        else { src = xin + ((size_t)b * SEQ + p - CTXL) * DM; mrow = b; }
        const float* sh = mod + mrow * 6144 + (which ? 3 : 0) * 1024; const float* sc = sh + 1024;
        f32x4 v[4]; float s = 0.f;
#pragma unroll
        for (int j = 0; j < 4; ++j) { v[j] = ((const GAS f32x4*)src)[F.lane + 64 * j]; s += v[j][0] * v[j][0] + v[j][1] * v[j][1] + v[j][2] * v[j][2] + v[j][3] * v[j][3]; }
        if (l == 0 && !which && p < CTXL) {
            float* cs = (float*)(ws + WS_CTXS) + ((size_t)b * CTXL + p) * DM;
#pragma unroll
            for (int j = 0; j < 4; ++j) ((GAS f32x4*)cs)[F.lane + 64 * j] = v[j]; }
        if (l == 0 && which && p < CTXL) {
            const float* pb = (const float*)(ws + WS_ZG) + ((size_t)bl * CTXL + p) * DM; const float* m2 = mod + 16 * 6144 + 2 * 1024; float* cs = (float*)(ws + WS_CTXS) + ((size_t)b * CTXL + p) * DM;
            s = 0.f;
#pragma unroll
            for (int j = 0; j < 4; ++j) { const int c = (F.lane + 64 * j) * 4; f32x4 a = *(const GAS f32x4*)(pb + c);
#pragma unroll
                for (int k2 = 1; k2 < 4; ++k2) a += *(const GAS f32x4*)(pb + (size_t)k2 * (GB * CTXL) * DM + c);
                v[j] += *(const GAS f32x4*)(m2 + c) * a; *(GAS f32x4*)(cs + c) = v[j];
                s += v[j][0] * v[j][0] + v[j][1] * v[j][1] + v[j][2] * v[j][2] + v[j][3] * v[j][3]; } }
        const float rstd = rsqrtf(wave_sum(s, F.lane) * (1.0f / DM) + EPS);
#pragma unroll
        for (int j = 0; j < 4; ++j) { const int c = (F.lane + 64 * j) * 4;
            const f32x4 gv = *(const GAS f32x4*)(gvec + c), sv = *(const GAS f32x4*)(sc + c), hv = *(const GAS f32x4*)(sh + c);
            const f32x4 y = v[j] * rstd * gv * (sv + 1.0f) + hv;
            u32x2 w; w.x = pk2(y[0], y[1]); w.y = pk2(y[2], y[3]);
            *(GAS u32x2*)(H + (size_t)r * DM + c) = w; }
    }
}

__device__ __forceinline__ void phase_ctxsum(const Ctx& F, int g) {
    unsigned char* ws = F.ws;
    const float* m5 = (const float*)(ws + WS_MOD) + 16 * 6144 + 5 * 1024;
    for (int r = blockIdx.x * 8 + F.wave; r < GB * CTXL; r += gridDim.x * 8) {
        const float* pb = (const float*)(ws + WS_Z1) + (size_t)r * DM; float* cs = (float*)(ws + WS_CTXS) + ((size_t)g * GB * CTXL + r) * DM;
#pragma unroll
        for (int j = 0; j < 4; ++j) { const int c = (F.lane + 64 * j) * 4; f32x4 a = *(const GAS f32x4*)(pb + c);
#pragma unroll
            for (int k2 = 1; k2 < 8; ++k2) a += *(const GAS f32x4*)(pb + (size_t)k2 * (GB * CTXL) * DM + c);
            *(GAS f32x4*)(cs + c) = *(const GAS f32x4*)(cs + c) + *(const GAS f32x4*)(m5 + c) * a; }
    }
}

__device__ __forceinline__ void phase_final(const Ctx& F) {
    const Params& P = *F.P;
    const float* gvec = P.in[26];
    for (int r = blockIdx.x * 8 + F.wave; r < NB * SEQ; r += gridDim.x * 8) {
        float* row = P.out + (size_t)r * DM;
        f32x4 v[4]; float s = 0.f;
#pragma unroll
        for (int j = 0; j < 4; ++j) { v[j] = ((const GAS f32x4*)row)[F.lane + 64 * j]; s += v[j][0] * v[j][0] + v[j][1] * v[j][1] + v[j][2] * v[j][2] + v[j][3] * v[j][3]; }
        const float rstd = rsqrtf(wave_sum(s, F.lane) * (1.0f / DM) + EPS);
#pragma unroll
        for (int j = 0; j < 4; ++j) { const int c = (F.lane + 64 * j) * 4; const f32x4 gv = *(const GAS f32x4*)(gvec + c);
            ((GAS f32x4*)row)[F.lane + 64 * j] = v[j] * rstd * gv; }
    }
}

__device__ __forceinline__ void phase_rowstats(const Ctx& F, int l) {
    const Params& P = *F.P; unsigned char* ws = F.ws;
    bf16_t* QC = (bf16_t*)(ws + WS_H);
    const float* cwt = P.in[8] + (size_t)l * 3 * 1024; const float* cbs = P.in[9] + (size_t)l * 1024;
    const bf16_t* Z1 = (const bf16_t*)(ws + WS_Z1); float* RS = (float*)(ws + WS_RS); bf16_t* KR = (bf16_t*)(ws + WS_KR);
    const float* rope = (const float*)(ws + WS_ROPE);
    for (int r = blockIdx.x * 8 + F.wave; r < T; r += gridDim.x * 8) {
        const bf16_t* zr = Z1 + (size_t)r * NZ1;
        float sq = 0.f, sk = 0.f;
#pragma unroll
        for (int j = 0; j < 3; ++j) { const unsigned w = *(const GAS unsigned*)(zr + ZCQ + j * 128 + 2 * F.lane); const float a = bflo(w), b = bfhi(w); sq += a * a + b * b; }
#pragma unroll
        for (int j = 0; j < 2; ++j) { const unsigned w = *(const GAS unsigned*)(zr + ZCKV + j * 128 + 2 * F.lane); const float a = bflo(w), b = bfhi(w); sk += a * a + b * b; }
        sq = wave_sum(sq, F.lane); sk = wave_sum(sk, F.lane);
        if (F.lane == 0) { RS[r * 2] = rsqrtf(sq * (1.0f / 384.0f) + EPS); RS[r * 2 + 1] = rsqrtf(sk * (1.0f / 256.0f) + EPS); }
        if (F.lane < 32) { const unsigned w = *(const GAS unsigned*)(zr + ZKR + 2 * F.lane); float x1 = bflo(w), x2 = bfhi(w);
            const int p = r % SEQT;
            if (p >= CTXL) { const f32x2 cs = ((const GAS f32x2*)rope)[(size_t)(p - CTXL) * 32 + F.lane]; const float a = x1 * cs.x - x2 * cs.y, b = x1 * cs.y + x2 * cs.x; x1 = a; x2 = b; }
            *(GAS unsigned*)(KR + (size_t)r * 64 + 2 * F.lane) = pk2(x1, x2); }
        {
            const int p = r % SEQT; const bool hp = (p != 0) && (p != CTXL), hn = (p != CTXL - 1) && (p != SEQT - 1);
            const u32x4 z4 = (u32x4){0u, 0u, 0u, 0u};
#pragma unroll
            for (int which = 0; which < 2; ++which) { const int col = which * 512 + F.lane * 8;
                const u32x4 xp = hp ? *(const GAS u32x4*)(zr - NZ1 + col) : z4, xc = *(const GAS u32x4*)(zr + col), xn = hn ? *(const GAS u32x4*)(zr + NZ1 + col) : z4;
                const float osc = which ? 0.08838834764831845f : 1.0f;
                float y[8];
#pragma unroll
                for (int e = 0; e < 8; ++e) { const unsigned wp = e < 2 ? xp.x : e < 4 ? xp.y : e < 6 ? xp.z : xp.w, wc_ = e < 2 ? xc.x : e < 4 ? xc.y : e < 6 ? xc.z : xc.w, wn = e < 2 ? xn.x : e < 4 ? xn.y : e < 6 ? xn.z : xn.w;
                    const float a = cbs[col + e] + cwt[col + e] * ((e & 1) ? bfhi(wp) : bflo(wp)) + cwt[1024 + col + e] * ((e & 1) ? bfhi(wc_) : bflo(wc_)) + cwt[2048 + col + e] * ((e & 1) ? bfhi(wn) : bflo(wn));
                    y[e] = siluf_(a) * osc; }
                u32x4 wv; wv.x = pk2(y[0], y[1]); wv.y = pk2(y[2], y[3]); wv.z = pk2(y[4], y[5]); wv.w = pk2(y[6], y[7]);
                *(GAS u32x4*)(QC + (size_t)r * 1024 + col) = wv; }
        }
    }
}

__device__ __forceinline__ void phase_mout(const Ctx& F, int l) {
    const Params& P = *F.P; unsigned char* ws = F.ws;
    const bf16_t* Z1 = (const bf16_t*)(ws + WS_Z1); const bf16_t* HF = (const bf16_t*)(ws + WS_HF); const bf16_t* HB = (const bf16_t*)(ws + WS_HB);
    bf16_t* Y = (bf16_t*)(ws + WS_Y); const float* gh = P.in[11] + l * 512;
    for (int r = blockIdx.x * 8 + F.wave; r < T; r += gridDim.x * 8) {
        if (l == 1 && (r % SEQT) < CTXL) continue;
        const int c = 8 * F.lane;
        const u32x4 a = *(const GAS u32x4*)(HF + (size_t)r * 512 + c), b = *(const GAS u32x4*)(HB + (size_t)r * 512 + c), o = *(const GAS u32x4*)(Z1 + (size_t)r * NZ1 + ZO + c);
        float h[8];
        h[0] = bflo(a.x) + bflo(b.x); h[1] = bfhi(a.x) + bfhi(b.x); h[2] = bflo(a.y) + bflo(b.y); h[3] = bfhi(a.y) + bfhi(b.y);
        h[4] = bflo(a.z) + bflo(b.z); h[5] = bfhi(a.z) + bfhi(b.z); h[6] = bflo(a.w) + bflo(b.w); h[7] = bfhi(a.w) + bfhi(b.w);
        float s = 0.f;
#pragma unroll
        for (int i = 0; i < 8; ++i) s += h[i] * h[i];
        s += shx(s, 1, F.lane); s += shx(s, 2, F.lane); s += shx(s, 4, F.lane); s += shx(s, 8, F.lane);
        const float rstd = rsqrtf(s * (1.0f / 128.0f) + EPS);
        float og[8];
        og[0] = bflo(o.x); og[1] = bfhi(o.x); og[2] = bflo(o.y); og[3] = bfhi(o.y); og[4] = bflo(o.z); og[5] = bfhi(o.z); og[6] = bflo(o.w); og[7] = bfhi(o.w);
        const f32x4 g0 = *(const GAS f32x4*)(gh + c), g1 = *(const GAS f32x4*)(gh + c + 4);
        float y[8];
#pragma unroll
        for (int i = 0; i < 8; ++i) y[i] = sigmoidf_(og[i]) * (h[i] * rstd * (i < 4 ? g0[i & 3] : g1[i & 3]));
        u32x4 w; w.x = pk2(y[0], y[1]); w.y = pk2(y[2], y[3]); w.z = pk2(y[4], y[5]); w.w = pk2(y[6], y[7]);
        *(GAS u32x4*)(Y + (size_t)r * 1536 + c) = w;
    }
}

__device__ __forceinline__ void phase_ffedge(const Ctx& F, int l) {
    const Params& P = *F.P; unsigned char* ws = F.ws;
    const bf16_t* EDGE = (const bf16_t*)(ws + WS_EDGE); bf16_t* Hd = (bf16_t*)(ws + WS_HID);
    const float* wc = P.in[23] + (size_t)l * 3 * 5632; const float* bc = P.in[24] + (size_t)l * 5632;
    const int ntask = 72 * 4 * 2 * 704;
    for (int q = blockIdx.x * NTHREADS + F.tid; q < ntask; q += gridDim.x * NTHREADS) {
        const int cg4 = q % 704, e = q / 704; const int bot = e & 1, blk = (e >> 1) & 3, tile = e >> 3; const int c = cg4 * 4;
        const int j9 = tile % 9;
        if (l == 1 && j9 == 0) continue;
        const bf16_t* eb = EDGE + ((size_t)(tile * 4 + blk) * 4) * 5632;
        const bf16_t *rp, *rc, *rn; bool hp = true, hn = true;
        if (!bot) { rc = eb; rn = eb + 5632;
            if (blk > 0) rp = eb - 5632;
            else { hp = !(j9 == 0 || j9 == 1); rp = eb - 5632; }
        } else { rc = eb + 3 * 5632; rp = eb + 2 * 5632;
            if (blk < 3) rn = eb + 4 * 5632;
            else { hn = !(j9 == 0 || j9 == 8); rn = eb + 4 * 5632; }
        }
        const u32x2 z2 = (u32x2){0u, 0u};
        const u32x2 gp = hp ? *(const GAS u32x2*)(rp + c) : z2, gc = *(const GAS u32x2*)(rc + c), gn = hn ? *(const GAS u32x2*)(rn + c) : z2;
        const u32x2 vp = hp ? *(const GAS u32x2*)(rp + DFF + c) : z2, vc = *(const GAS u32x2*)(rc + DFF + c), vn = hn ? *(const GAS u32x2*)(rn + DFF + c) : z2;
        const f32x4 wg0 = *(const GAS f32x4*)(wc + c), wg1 = *(const GAS f32x4*)(wc + 5632 + c), wg2 = *(const GAS f32x4*)(wc + 2 * 5632 + c), bg = *(const GAS f32x4*)(bc + c);
        const f32x4 wv0 = *(const GAS f32x4*)(wc + DFF + c), wv1 = *(const GAS f32x4*)(wc + 5632 + DFF + c), wv2 = *(const GAS f32x4*)(wc + 2 * 5632 + DFF + c), bv = *(const GAS f32x4*)(bc + DFF + c);
        float o[4];
#pragma unroll
        for (int j = 0; j < 4; ++j) {
            const unsigned a0 = j < 2 ? gp.x : gp.y, a1 = j < 2 ? gc.x : gc.y, a2 = j < 2 ? gn.x : gn.y, b0 = j < 2 ? vp.x : vp.y, b1 = j < 2 ? vc.x : vc.y, b2 = j < 2 ? vn.x : vn.y;
            const float cgv = bg[j] + wg0[j] * ((j & 1) ? bfhi(a0) : bflo(a0)) + wg1[j] * ((j & 1) ? bfhi(a1) : bflo(a1)) + wg2[j] * ((j & 1) ? bfhi(a2) : bflo(a2));
            const float cvv = bv[j] + wv0[j] * ((j & 1) ? bfhi(b0) : bflo(b0)) + wv1[j] * ((j & 1) ? bfhi(b1) : bflo(b1)) + wv2[j] * ((j & 1) ? bfhi(b2) : bflo(b2));
            o[j] = siluf_(cgv) * cvv;
        }
        u32x2 w; w.x = pk2(o[0], o[1]); w.y = pk2(o[2], o[3]);
        *(GAS u32x2*)(Hd + (size_t)(tile * 256 + blk * 64 + (bot ? 63 : 0)) * DFF + c) = w;
    }
}

constexpr int LP = 136;
__device__ __forceinline__ void sgu_unit(const Ctx& F_, int l, int bl, int c, int gi) {
    Ctx F = F_; { int t_ = F_.lane; asm volatile("" : "+v"(t_)); int w_ = F_.wave; asm volatile("" : "+s"(w_)); F.lane = t_; F.wave = w_; F.tid = w_ * 64 + t_; }
    const Params& P = *F.P; unsigned char* ws = F.ws;
    const bf16_t* Z1 = (const bf16_t*)(ws + WS_Z1); bf16_t* Y = (bf16_t*)(ws + WS_Y);
    LAS bf16_t* Ws = (LAS bf16_t*)F.lds; LAS bf16_t* VnT = Ws + 128 * LP;
    const int R0 = bl * SEQT + c * 128;
    const int t = F.tid, s = t >> 2, cb = (t & 3) * 32;
    {
        const float* wsrc = P.in[17] + (((size_t)l * 4 + gi) * 128 + s) * 128 + cb;
#pragma unroll
        for (int i = 0; i < 4; ++i) { const f32x4 a = *(const GAS f32x4*)(wsrc + i * 8), b = *(const GAS f32x4*)(wsrc + i * 8 + 4);
            u32x4 w; w.x = pk2(a[0], a[1]); w.y = pk2(a[2], a[3]); w.z = pk2(b[0], b[1]); w.w = pk2(b[2], b[3]);
            *(LAS u32x4*)(Ws + s * LP + cb + i * 8) = w; }
        const bf16_t* vsrc = Z1 + (size_t)(R0 + s) * NZ1 + ZS + gi * 128 + cb;
        float v[32]; float sq = 0.f;
#pragma unroll
        for (int i = 0; i < 4; ++i) { const u32x4 w = *(const GAS u32x4*)(vsrc + i * 8);
            v[i * 8 + 0] = geluf_(bflo(w.x)); v[i * 8 + 1] = geluf_(bfhi(w.x)); v[i * 8 + 2] = geluf_(bflo(w.y)); v[i * 8 + 3] = geluf_(bfhi(w.y));
            v[i * 8 + 4] = geluf_(bflo(w.z)); v[i * 8 + 5] = geluf_(bfhi(w.z)); v[i * 8 + 6] = geluf_(bflo(w.w)); v[i * 8 + 7] = geluf_(bfhi(w.w)); }
#pragma unroll
        for (int i = 0; i < 32; ++i) sq += v[i] * v[i];
        sq += shx(sq, 1, F.lane); sq += shx(sq, 2, F.lane);
        const float rstd = rsqrtf(sq * (1.0f / 128.0f) + EPS);
        const float* gs = P.in[16] + l * 512 + gi * 128 + cb;
#pragma unroll
        for (int i = 0; i < 32; ++i) VnT[(cb + i) * LP + s] = f2bf(v[i] * rstd * gs[i]);
    }
    __syncthreads();
    const int fr = F.lane & 15, fq = F.lane >> 4, w = F.wave;
    f32x4 acc[8];
#pragma unroll
    for (int ct = 0; ct < 8; ++ct) acc[ct] = (f32x4){0.f, 0.f, 0.f, 0.f};
#pragma unroll
    for (int kk = 0; kk < 4; ++kk) {
        const bf16x8 bfr = *(const LAS bf16x8*)(Ws + (w * 16 + fr) * LP + kk * 32 + fq * 8);
#pragma unroll
        for (int ct = 0; ct < 8; ++ct) { const bf16x8 afr = *(const LAS bf16x8*)(VnT + (ct * 16 + fr) * LP + kk * 32 + fq * 8); acc[ct] = mfma16(afr, bfr, acc[ct]); }
    }
    const int tt = w * 16 + fr; const float bsv = P.in[18][((size_t)l * 4 + gi) * 128 + tt];
    const bf16_t* usrc = Z1 + (size_t)(R0 + tt) * NZ1 + ZU + gi * 128; bf16_t* yd = Y + (size_t)(R0 + tt) * 1536 + 1024 + gi * 128;
#pragma unroll
    for (int ct = 0; ct < 8; ++ct) { const int ch = ct * 16 + fq * 4; const u32x2 uw = *(const GAS u32x2*)(usrc + ch);
        const float o0 = geluf_(bflo(uw.x)) * (acc[ct][0] + bsv), o1 = geluf_(bfhi(uw.x)) * (acc[ct][1] + bsv), o2 = geluf_(bflo(uw.y)) * (acc[ct][2] + bsv), o3 = geluf_(bfhi(uw.y)) * (acc[ct][3] + bsv);
        u32x2 ow; ow.x = pk2(o0, o1); ow.y = pk2(o2, o3); *(GAS u32x2*)(yd + ch) = ow; }
}

constexpr int KP = 208, VP = 80;
constexpr int ATT_BUF = (64 * KP + 128 * VP) * 2;
constexpr int ANT = 2;
__device__ __forceinline__ void attn_unit(const Ctx& F_, int bl, int h, int qrow0, int nkt) {
    Ctx F = F_; { int t_ = F_.lane; asm volatile("" : "+v"(t_)); int w_ = F_.wave; asm volatile("" : "+s"(w_)); F.lane = t_; F.wave = w_; F.tid = w_ * 64 + t_; }
    unsigned char* ws = F.ws;
    const bf16_t* QA = (const bf16_t*)(ws + WS_QA);
    const char* KNb = (const char*)(ws + WS_KV) + ((size_t)bl * SEQT * 512 + h * 128) * 2;
    const char* KRb = (const char*)(ws + WS_KR) + (size_t)bl * SEQT * 64 * 2;
    const char* VTb = (const char*)(ws + WS_KV) + ((size_t)T * 512 + (size_t)((bl * 4 + h) * 128) * SEQT) * 2;
    bf16_t* Y = (bf16_t*)(ws + WS_Y);
    const int t = F.tid, fr = F.lane & 15, fq = F.lane >> 4, w = F.wave;
    unsigned kofs[4]; int ksel[4]; unsigned vofs[3];
#pragma unroll
    for (int i = 0; i < 4; ++i) { const int q = i * 512 + t; const int row = q / 26, pc = q % 26; const int pcc = pc >= 24 ? 0 : pc;
        ksel[i] = pcc >= 16; kofs[i] = pcc >= 16 ? (unsigned)(row * 64 + (pcc - 16) * 8) * 2u : (unsigned)(row * 512 + pcc * 8) * 2u; }
#pragma unroll
    for (int i = 0; i < 3; ++i) { const int q = i * 512 + t; const int row = q / 10, pc = q % 10; vofs[i] = (unsigned)(row * SEQT + (pc >= 8 ? 0 : pc) * 8) * 2u; }
#define ATT_DMA(kt, bufi) do { LAS unsigned char* kb_ = F.lds + (bufi) * ATT_BUF; const char* kn_ = KNb + (size_t)(kt) * 64 * 512 * 2; const char* kr_ = KRb + (size_t)(kt) * 64 * 64 * 2; const char* vt_ = VTb + (size_t)(kt) * 64 * 2; \
        _Pragma("unroll") for (int i_ = 0; i_ < 4; ++i_) { if (i_ < 3 || t < 128) __builtin_amdgcn_global_load_lds((const GAS unsigned*)((ksel[i_] ? kr_ : kn_) + kofs[i_]), (LAS unsigned*)(kb_ + (i_ * 512 + w * 64) * 16), 16, 0, 0); } \
        _Pragma("unroll") for (int i_ = 0; i_ < 3; ++i_) { if (i_ < 2 || t < 256) __builtin_amdgcn_global_load_lds((const GAS unsigned*)(vt_ + vofs[i_]), (LAS unsigned*)(kb_ + 64 * KP * 2 + (i_ * 512 + w * 64) * 16), 16, 0, 0); } } while (0)
    ATT_DMA(0, 0);
    bf16x8 qf[ANT][6];
#pragma unroll
    for (int tt = 0; tt < ANT; ++tt)
#pragma unroll
        for (int kk = 0; kk < 6; ++kk) qf[tt][kk] = *(const GAS bf16x8*)(QA + (size_t)(qrow0 + w * (16 * ANT) + tt * 16 + fr) * 768 + h * 192 + kk * 32 + fq * 8);
    f32x4 o[8][ANT];
#pragma unroll
    for (int et = 0; et < 8; ++et)
#pragma unroll
        for (int tt = 0; tt < ANT; ++tt) o[et][tt] = (f32x4){0.f, 0.f, 0.f, 0.f};
    float mrun[ANT], lrun[ANT];
#pragma unroll
    for (int tt = 0; tt < ANT; ++tt) { mrun[tt] = -1e30f; lrun[tt] = 0.f; }
    asm volatile("s_waitcnt vmcnt(0)" ::: "memory");
    __syncthreads();
    for (int kt = 0; kt < nkt; ++kt) {
        if (kt + 1 < nkt) ATT_DMA(kt + 1, (kt + 1) & 1);
        const LAS bf16_t* Ks = (const LAS bf16_t*)(F.lds + (kt & 1) * ATT_BUF); const LAS bf16_t* Vt = Ks + 64 * KP;
        f32x4 s[4][ANT];
#pragma unroll
        for (int st = 0; st < 4; ++st)
#pragma unroll
            for (int tt = 0; tt < ANT; ++tt) s[st][tt] = (f32x4){0.f, 0.f, 0.f, 0.f};
        bf16x8 kf[2][4];
#pragma unroll
        for (int st = 0; st < 4; ++st) kf[0][st] = *(const LAS bf16x8*)(Ks + (st * 16 + fr) * KP + fq * 8);
#pragma unroll
        for (int kk = 0; kk < 6; ++kk) {
            if (kk < 5) {
#pragma unroll
                for (int st = 0; st < 4; ++st) kf[(kk + 1) & 1][st] = *(const LAS bf16x8*)(Ks + (st * 16 + fr) * KP + (kk + 1) * 32 + fq * 8);
            }
            __builtin_amdgcn_sched_barrier(0);
#pragma unroll
            for (int st = 0; st < 4; ++st)
#pragma unroll
                for (int tt = 0; tt < ANT; ++tt) s[st][tt] = mfma16(kf[kk & 1][st], qf[tt][kk], s[st][tt]);
            __builtin_amdgcn_sched_barrier(0);
        }
        bf16x8 vf[2][4];
#pragma unroll
        for (int e4 = 0; e4 < 4; ++e4) vf[0][e4] = *(const LAS bf16x8*)(Vt + (e4 * 16 + fr) * VP + fq * 8);
        bf16x8 pf[ANT][2];
        float mx[ANT];
#pragma unroll
        for (int tt = 0; tt < ANT; ++tt) { float m_ = -1e30f;
#pragma unroll
            for (int st = 0; st < 4; ++st) m_ = fmaxf(m_, fmaxf(fmaxf(s[st][tt][0], s[st][tt][1]), fmaxf(s[st][tt][2], s[st][tt][3])));
            mx[tt] = m_; }
#pragma unroll
        for (int tt = 0; tt < ANT; ++tt) mx[tt] = fmaxf(mx[tt], shx(mx[tt], 16, F.lane));
#pragma unroll
        for (int tt = 0; tt < ANT; ++tt) mx[tt] = fmaxf(mx[tt], shx(mx[tt], 32, F.lane));
#pragma unroll
        for (int tt = 0; tt < ANT; ++tt) {
            const bool need = mx[tt] > mrun[tt] + 8.0f;
            if (__builtin_amdgcn_ballot_w64(need) != 0ull) {
                const float mn = need ? mx[tt] : mrun[tt], alpha = __builtin_amdgcn_exp2f(mrun[tt] - mn);
                mrun[tt] = mn; lrun[tt] *= alpha;
#pragma unroll
                for (int et = 0; et < 8; ++et) o[et][tt] *= alpha;
            }
            const float mref = mrun[tt];
            float ps = 0.f;
#pragma unroll
            for (int st = 0; st < 4; ++st)
#pragma unroll
                for (int j = 0; j < 4; ++j) { const float p = __builtin_amdgcn_exp2f(s[st][tt][j] - mref); s[st][tt][j] = p; ps += p; }
            lrun[tt] += ps;
#pragma unroll
            for (int kk = 0; kk < 2; ++kk) { u32x4 pw; pw.x = pk2(s[2 * kk][tt][0], s[2 * kk][tt][1]); pw.y = pk2(s[2 * kk][tt][2], s[2 * kk][tt][3]);
                pw.z = pk2(s[2 * kk + 1][tt][0], s[2 * kk + 1][tt][1]); pw.w = pk2(s[2 * kk + 1][tt][2], s[2 * kk + 1][tt][3]);
                pf[tt][kk] = __builtin_bit_cast(bf16x8, pw); }
        }
#pragma unroll
        for (int gi = 0; gi < 4; ++gi) {
            const int kk = gi >> 1, eb = (gi & 1) * 4;
            if (gi < 3) { const int kk2 = (gi + 1) >> 1, eb2 = ((gi + 1) & 1) * 4;
#pragma unroll
                for (int e4 = 0; e4 < 4; ++e4) vf[(gi + 1) & 1][e4] = *(const LAS bf16x8*)(Vt + ((eb2 + e4) * 16 + fr) * VP + kk2 * 32 + fq * 8);
            }
            __builtin_amdgcn_sched_barrier(0);
#pragma unroll
            for (int e4 = 0; e4 < 4; ++e4)
#pragma unroll
                for (int tt = 0; tt < ANT; ++tt) o[eb + e4][tt] = mfma16(vf[gi & 1][e4], pf[tt][kk], o[eb + e4][tt]);
            __builtin_amdgcn_sched_barrier(0);
        }
        asm volatile("s_waitcnt vmcnt(0)" ::: "memory");
        __syncthreads();
    }
#undef ATT_DMA
#pragma unroll
    for (int tt = 0; tt < ANT; ++tt) {
        float lt = lrun[tt]; lt += shx(lt, 16, F.lane); lt += shx(lt, 32, F.lane);
        const float inv = 1.0f / lt;
        bf16_t* yd = Y + (size_t)(qrow0 + w * (16 * ANT) + tt * 16 + fr) * 1536 + 512 + h * 128;
#pragma unroll
        for (int et = 0; et < 8; ++et) { u32x2 ow; ow.x = pk2(o[et][tt][0] * inv, o[et][tt][1] * inv); ow.y = pk2(o[et][tt][2] * inv, o[et][tt][3] * inv);
            *(GAS u32x2*)(yd + et * 16 + fq * 4) = ow; }
    }
}

__device__ __forceinline__ void mlstm_chain(const Ctx& F_, int l, int bl, int h, int dir) {
    Ctx F = F_; { int t_ = F_.lane; asm volatile("" : "+v"(t_)); int w_ = F_.wave; asm volatile("" : "+s"(w_)); F.lane = t_; F.wave = w_; F.tid = w_ * 64 + t_; }
    const Params& P = *F.P; unsigned char* ws = F.ws;
    const bf16_t* Z1 = (const bf16_t*)(ws + WS_Z1);
    bf16_t* HO = (bf16_t*)(ws + (dir ? WS_HB : WS_HF));
    LAS bf16_t* Qs = (LAS bf16_t*)F.lds; LAS bf16_t* Ks = Qs + 128 * LP; LAS bf16_t* VTs = Ks + 128 * LP; LAS bf16_t* CTs = VTs + 144 * LP;
    LAS float* fb = (LAS float*)(CTs + 144 * LP);
    LAS float* gI = fb, *gF = fb + 128, *sA = fb + 256, *sM = fb + 384, *sB = fb + 512, *sW = fb + 640, *cw = fb + 768;
    const int t = F.tid, fr = F.lane & 15, fq = F.lane >> 4, w = F.wave;
    for (int i = t; i < 1024; i += NTHREADS) { const int which = i >> 9, j = (i >> 7) & 3, c = i & 127; const int col = which * 512 + h * 128 + c;
        cw[i] = j < 3 ? P.in[8][((size_t)l * 3 + j) * 1024 + col] : P.in[9][(size_t)l * 1024 + col]; }
    for (int i = t; i < 16 * LP; i += NTHREADS) VTs[128 * LP + i] = (i < LP) ? (bf16_t)0x3F80 : (bf16_t)0;
    for (int i = t; i < 144 * LP; i += NTHREADS) CTs[i] = 0;
    const float bgi = P.in[10][l * 16 + dir * 8 + h], bgf = P.in[10][l * 16 + dir * 8 + 4 + h];
    f32x4 cta[9];
#pragma unroll
    for (int et = 0; et < 9; ++et) cta[et] = (f32x4){0.f, 0.f, 0.f, 0.f};
    float mstate = 0.f;
    const int tau_s = t >> 2, cb = (t & 3) * 32;
    u32x4 rq[4], rk[4], rv[4];
#define ML_CHUNK(step) (dir == 0 ? (step) : ((step) < 2 ? 1 - (step) : 19 - (step)))
#define ML_LOAD(step) do { const int R0_ = bl * SEQT + ML_CHUNK(step) * 128; const int r_ = dir ? R0_ + 127 - tau_s : R0_ + tau_s; \
        const bf16_t* qb_ = (const bf16_t*)(ws + WS_H) + (size_t)r_ * 1024 + h * 128 + cb; const bf16_t* vb_ = Z1 + (size_t)r_ * NZ1 + ZV + h * 128 + cb; \
        _Pragma("unroll") for (int i_ = 0; i_ < 4; ++i_) { rq[i_] = *(const GAS u32x4*)(qb_ + i_ * 8); rk[i_] = *(const GAS u32x4*)(qb_ + 512 + i_ * 8); rv[i_] = *(const GAS u32x4*)(vb_ + i_ * 8); } } while (0)
    ML_LOAD(0);
    for (int step = 0; step < 18; ++step) {
        const int c = dir == 0 ? step : (step < 2 ? 1 - step : 19 - step);
        const int R0 = bl * SEQT + c * 128;
        const int seq_lo = c < 2 ? bl * SEQT : bl * SEQT + CTXL, seq_hi = c < 2 ? bl * SEQT + CTXL : (bl + 1) * SEQT;
        __syncthreads();
        if (step > 0) {
#pragma unroll
            for (int et = 0; et < 9; ++et)
#pragma unroll
                for (int j = 0; j < 4; ++j) CTs[(et * 16 + fq * 4 + j) * LP + w * 16 + fr] = f2bf(cta[et][j]);
        }
        {
            const int r = dir ? R0 + 127 - tau_s : R0 + tau_s;
            const bool hp = (r - 1) >= seq_lo, hn = (r + 1) < seq_hi;
            const u32x4 z4 = (u32x4){0u, 0u, 0u, 0u};
#pragma unroll
            for (int i = 0; i < 4; ++i) { *(LAS u32x4*)(Qs + tau_s * LP + cb + i * 8) = rq[i]; *(LAS u32x4*)(Ks + tau_s * LP + cb + i * 8) = rk[i]; }
            (void)hp; (void)hn; (void)z4;
#pragma unroll
            for (int i = 0; i < 4; ++i) { const u32x4 xv = rv[i]; LAS bf16_t* vp = VTs + (cb + i * 8) * LP + (tau_s ^ ((t & 3) << 4));
                vp[0 * LP] = (bf16_t)(xv.x & 0xffff); vp[1 * LP] = (bf16_t)(xv.x >> 16); vp[2 * LP] = (bf16_t)(xv.y & 0xffff); vp[3 * LP] = (bf16_t)(xv.y >> 16);
                vp[4 * LP] = (bf16_t)(xv.z & 0xffff); vp[5 * LP] = (bf16_t)(xv.z >> 16); vp[6 * LP] = (bf16_t)(xv.w & 0xffff); vp[7 * LP] = (bf16_t)(xv.w >> 16); }
            if (t < 128) { const int rg = dir ? R0 + 127 - t : R0 + t; const GAS bf16_t* gp = (const GAS bf16_t*)(Z1 + (size_t)rg * NZ1 + ZMG + dir * 8 + h);
                gI[t] = bf2f(gp[0]) + bgi; gF[t] = logsigmoidf_(bf2f(gp[4]) + bgf); }
        }
        __syncthreads();
        if (step + 1 < 18) ML_LOAD(step + 1);
        float M127, wcdec, mnew;
        {
            const float f0 = gF[2 * F.lane], f1 = gF[2 * F.lane + 1];
            const float ps = f0 + f1; float inc = ps;
#pragma unroll
            for (int o2 = 1; o2 < 64; o2 <<= 1) { const float u = shi(inc, F.lane - o2); if (F.lane >= o2) inc += u; }
            const float b0 = inc - ps + f0, b1 = inc;
            const float a0 = gI[2 * F.lane] - b0, a1 = gI[2 * F.lane + 1] - b1;
            float cmi = fmaxf(a0, a1);
#pragma unroll
            for (int o2 = 1; o2 < 64; o2 <<= 1) { const float u = shi(cmi, F.lane - o2); if (F.lane >= o2) cmi = fmaxf(cmi, u); }
            float cme = shi(cmi, F.lane - 1); if (F.lane == 0) cme = -1e30f;
            const float M0 = fmaxf(mstate, fmaxf(cme, a0)), M1 = fmaxf(mstate, cmi);
            M127 = shi(M1, 63); const float blast = shi(b1, 63);
            sA[2 * F.lane] = a0; sA[2 * F.lane + 1] = a1; sM[2 * F.lane] = M0; sM[2 * F.lane + 1] = M1; sB[2 * F.lane] = b0; sB[2 * F.lane + 1] = b1;
            sW[2 * F.lane] = __expf(a0 - M127); sW[2 * F.lane + 1] = __expf(a1 - M127);
            wcdec = __expf(mstate - M127); mnew = blast + M127;
        }
        asm volatile("s_waitcnt lgkmcnt(0)" ::: "memory");
        const int tau = w * 16 + fr;
        const float Mt = sM[tau];
        bf16x8 qf[4];
#pragma unroll
        for (int kk = 0; kk < 4; ++kk) qf[kk] = *(const LAS bf16x8*)(Qs + tau * LP + kk * 32 + fq * 8);
        bf16x8 pf[4];
#pragma unroll
        for (int kk = 0; kk < 4; ++kk) {
            u32x4 pw = (u32x4){0u, 0u, 0u, 0u};
#pragma unroll
            for (int hh = 0; hh < 2; ++hh) { const int st = 2 * kk + hh;
                if (st <= w) {
                    f32x4 sacc = (f32x4){0.f, 0.f, 0.f, 0.f};
#pragma unroll
                    for (int k2 = 0; k2 < 4; ++k2) { const bf16x8 kf = *(const LAS bf16x8*)(Ks + (st * 16 + fr) * LP + k2 * 32 + fq * 8); sacc = mfma16(kf, qf[k2], sacc); }
                    const f32x4 av = *(const LAS f32x4*)(sA + st * 16 + fq * 4);
                    float p[4];
#pragma unroll
                    for (int j = 0; j < 4; ++j) { const int sg = st * 16 + fq * 4 + j; p[j] = sg <= tau ? sacc[j] * __expf(av[j] - Mt) : 0.f; }
                    if (hh == 0) { pw.x = pk2(p[0], p[1]); pw.y = pk2(p[2], p[3]); } else { pw.z = pk2(p[0], p[1]); pw.w = pk2(p[2], p[3]); }
                }
            }
            pf[kk] = __builtin_bit_cast(bf16x8, pw);
        }
        f32x4 nt[9];
#pragma unroll
        for (int et = 0; et < 9; ++et) nt[et] = (f32x4){0.f, 0.f, 0.f, 0.f};
#pragma unroll
        for (int kk = 0; kk < 4; ++kk)
#pragma unroll
            for (int et = 0; et < 9; ++et) { const bf16x8 cf = *(const LAS bf16x8*)(CTs + (et * 16 + fr) * LP + kk * 32 + fq * 8); nt[et] = mfma16(cf, qf[kk], nt[et]); }
        const float winter = __expf(mstate - Mt);
#pragma unroll
        for (int et = 0; et < 9; ++et) nt[et] *= winter;
#pragma unroll
        for (int kk = 0; kk < 4; ++kk) {
            if (2 * kk <= w) {
#pragma unroll
                for (int et = 0; et < 9; ++et) { const int e = et * 16 + fr; const int swz = ((e >> 5) & 3) << 4; const LAS bf16_t* vrow = VTs + e * LP;
                    const u32x2 a0 = *(const LAS u32x2*)(vrow + ((kk * 32 + fq * 4) ^ swz)), a1 = *(const LAS u32x2*)(vrow + ((kk * 32 + 16 + fq * 4) ^ swz));
                    u32x4 aw; aw.x = a0.x; aw.y = a0.y; aw.z = a1.x; aw.w = a1.y;
                    nt[et] = mfma16(__builtin_bit_cast(bf16x8, aw), pf[kk], nt[et]); }
            }
        }
        {
            const float den = shi(nt[8][0], fr);
            const float mt = sB[tau] + Mt;
            const float dn = fmaxf(fabsf(den), __expf(-mt));
            const float inv = 1.0f / dn;
            const int rr = dir ? R0 + 127 - tau : R0 + tau;
            bf16_t* hd = HO + (size_t)rr * 512 + h * 128;
#pragma unroll
            for (int et = 0; et < 8; ++et) { u32x2 ow; ow.x = pk2(nt[et][0] * inv, nt[et][1] * inv); ow.y = pk2(nt[et][2] * inv, nt[et][3] * inv); *(GAS u32x2*)(hd + et * 16 + fq * 4) = ow; }
        }
#pragma unroll
        for (int et = 0; et < 9; ++et) cta[et] *= wcdec;
#pragma unroll
        for (int kk = 0; kk < 4; ++kk) {
            const int s0 = kk * 32 + fq * 8;
            const f32x4 w0 = *(const LAS f32x4*)(sW + s0), w1 = *(const LAS f32x4*)(sW + s0 + 4);
            const LAS bf16_t* kcol = Ks + s0 * LP + w * 16 + fr;
            u32x4 bw;
            bw.x = pk2(bf2f(kcol[0 * LP]) * w0[0], bf2f(kcol[1 * LP]) * w0[1]); bw.y = pk2(bf2f(kcol[2 * LP]) * w0[2], bf2f(kcol[3 * LP]) * w0[3]);
            bw.z = pk2(bf2f(kcol[4 * LP]) * w1[0], bf2f(kcol[5 * LP]) * w1[1]); bw.w = pk2(bf2f(kcol[6 * LP]) * w1[2], bf2f(kcol[7 * LP]) * w1[3]);
            const bf16x8 bfr = __builtin_bit_cast(bf16x8, bw);
#pragma unroll
            for (int et = 0; et < 9; ++et) { const int e = et * 16 + fr; const int swz = ((e >> 5) & 3) << 4;
                const bf16x8 af = *(const LAS bf16x8*)(VTs + e * LP + (s0 ^ swz)); cta[et] = mfma16(af, bfr, cta[et]); }
        }
        mstate = mnew;
    }
}

__device__ __forceinline__ void phase_mixers(const Ctx& F, int l, int g, int rep) {
    unsigned* counter = (unsigned*)(F.ws + WS_CNT) + (l * 2 + g) * 4 + rep;
    LAS unsigned* slot = (LAS unsigned*)(F.lds + LDS_BYTES - 16);
    constexpr int QB = 2048 / (128 * ANT), CB = 256 / (128 * ANT);
    const int NL = GB * 4 * QB, NA = NL + (l == 0 ? GB * 4 * CB : 0), nch = (l == 0 ? 18 : 16), NS = GB * nch * 4;
    const int total = 64 + NA + NS;
    for (;;) {
        __syncthreads();
        if (F.tid == 0) *slot = __hip_atomic_fetch_add(counter, 1u, __ATOMIC_RELAXED, __HIP_MEMORY_SCOPE_AGENT);
        __syncthreads();
        int it = (int)*slot;
        if (it >= total) break;
        if (it < 64) { REP(7) { __syncthreads(); mlstm_chain(F, l, it >> 3, (it >> 1) & 3, it & 1); } continue; }
        it -= 64;
        if (it < NA) {
            if (it < NL) { const int bl = it / (4 * QB), h = (it / QB) & 3, qb = it % QB; REP(8) { __syncthreads(); attn_unit(F, bl, h, bl * SEQT + CTXL + qb * (128 * ANT), 36); } }
            else { const int ci = it - NL; const int bl = ci / (4 * CB), h = (ci / CB) & 3, cbk = ci % CB; attn_unit(F, bl, h, bl * SEQT + cbk * (128 * ANT), 4); }
            continue;
        }
        it -= NA;
        { const int bl = it / (nch * 4), rem = it % (nch * 4); sgu_unit(F, l, bl, (rem >> 2) + (l == 0 ? 0 : 2), rem & 3); }
    }
}

__global__ void __launch_bounds__(NTHREADS) fwd_megakernel(Params P) {
    extern __shared__ __attribute__((aligned(16))) unsigned char lds_raw[];
    cg::grid_group grid = cg::this_grid();
    Ctx F; F.lds = (LAS unsigned char*)lds_raw; F.wave = __builtin_amdgcn_readfirstlane(threadIdx.x >> 6); F.lane = 0; F.tid = 0; F.P = &P; F.ws = P.ws;
    const int wave0 = F.wave;
    const int G = gridDim.x, c = blockIdx.x;
    volatile LAS unsigned* bst = (volatile LAS unsigned*)(F.lds + LDS_BYTES - 32);
    { int t0_; asm volatile("v_mbcnt_lo_u32_b32 %0, -1, 0\n\tv_mbcnt_hi_u32_b32 %0, -1, %0" : "=v"(t0_));
      if (wave0 == 0 && t0_ < 2) bst[t0_] = 0u;
      __syncthreads();
      if (wave0 == 0 && t0_ == 0) (void)xb_add((unsigned*)(P.ws + WS_BAR) + XB_XCNT(xb_xcc_id()), 1u); }
#define GSYNC() do { REP(3) { int tb_; asm volatile("v_mbcnt_lo_u32_b32 %0, -1, 0\n\tv_mbcnt_hi_u32_b32 %0, -1, %0" : "=v"(tb_)); \
        xcd_barrier((unsigned*)(P.ws + WS_BAR), bst, wave0 == 0 && tb_ == 0); } } while (0)
#define REFRESH() int l = l_; int g = g_; unsigned char* ws = P.ws; do { int t_; asm volatile("v_mbcnt_lo_u32_b32 %0, -1, 0\n\tv_mbcnt_hi_u32_b32 %0, -1, %0" : "=v"(t_)); int w_ = wave0; asm volatile("" : "+s"(w_)); F.lane = t_; F.wave = w_; F.tid = w_ * 64 + t_; \
        asm volatile("" : "+s"(l)); asm volatile("" : "+s"(g)); asm volatile("" : "+s"(ws)); F.ws = ws; } while (0)
#define REFRESH_TID() do { int t_; asm volatile("v_mbcnt_lo_u32_b32 %0, -1, 0\n\tv_mbcnt_hi_u32_b32 %0, -1, %0" : "=v"(t_)); int w_ = wave0; asm volatile("" : "+s"(w_)); F.lane = t_; F.wave = w_; F.tid = w_ * 64 + t_; asm volatile("" : "+s"(l)); asm volatile("" : "+s"(g)); } while (0)
#pragma nounroll
    for (int l_ = 0; l_ < 2; ++l_) {
        REP(4) { const int g_ = 0; REFRESH(); (void)g; phase_prep(F, l, l == 0 ? 0 : 1864, -1, 0, G); }
        if (l_ == 0) grid.sync();
        { const int g_ = 0; REFRESH(); phase_norm(F, l, g, 0); }
        GSYNC();
#pragma nounroll
        for (int g_ = 0; g_ < NGRP; ++g_) {
            if (l_ == 0) { REFRESH(); (void)l; (void)g; pg8::Order S; S.init(72, NIN, G, c, 0); pg8::Gemm gm{(const bf16_t*)(ws + WS_H), (const bf16_t*)(ws + WS_WIN), 1024, NIN, 1024, 1024};
              EpiIn E{(bf16_t*)(ws + WS_Z1), (bf16_t*)(ws + WS_ZG)}; pg8::gemm_phase(F.lds, gm, S, E, F.tid); }
            else { REFRESH(); (void)l; (void)g; pg8::OrderL1In S; S.base.init(64, NIN, G, c, 1); pg8::Gemm gm{(const bf16_t*)(ws + WS_H), (const bf16_t*)(ws + WS_WIN), 1024, NIN, 1024, 1024};
              EpiIn E{(bf16_t*)(ws + WS_Z1), (bf16_t*)(ws + WS_ZG)}; pg8::gemm_phase(F.lds, gm, S, E, F.tid); }
            GSYNC();
            REP(2) { REFRESH(); (void)g; phase_rowstats(F, l); }
            GSYNC();
            REP(6) {
            { REFRESH(); (void)l; (void)g; pg8::Order S; S.init(72, 768, G, c, 0); pg8::Gemm gm{(const bf16_t*)(ws + WS_Z1) + ZCQ, (const bf16_t*)(ws + WS_WUQ), NZ1, 768, 384, 384};
              EpiQ E{(bf16_t*)(ws + WS_QA), (const float*)(ws + WS_RS), (const float*)(ws + WS_ROPE)}; pg8::gemm_phase(F.lds, gm, S, E, F.tid); }
            { REFRESH(); (void)l; (void)g; pg8::Order S; S.init(72, 512, G, (c + G - (216 % G)) % G, 0);     pg8::Gemm gm{(const bf16_t*)(ws + WS_Z1) + ZCKV, (const bf16_t*)(ws + WS_WUKV), NZ1, 512, 256, 256};
              EpiBf E{(bf16_t*)(ws + WS_KV), 512, (const float*)(ws + WS_RS) + 1}; pg8::gemm_phase(F.lds, gm, S, E, F.tid); }
            { REFRESH(); (void)l; (void)g; pg8::Order S; S.init(2, T, G, (c + G - (104 % G)) % G, 0); pg8::Gemm gm{(const bf16_t*)(ws + WS_WUKV) + (size_t)512 * 256, (const bf16_t*)(ws + WS_Z1) + ZCKV, 256, T, 256, NZ1};
              EpiVT E{(bf16_t*)(ws + WS_KV) + (size_t)T * 512, (const float*)(ws + WS_RS) + 1}; pg8::gemm_phase(F.lds, gm, S, E, F.tid); }
            }
            GSYNC();
            REP(0) { REFRESH(); phase_mixers(F, l, g, rep_); }
            GSYNC();
            REP(2) { REFRESH(); (void)g; phase_mout(F, l); }
            GSYNC();
            REP(5) { REFRESH(); (void)g; const int skip = (l == 1), nM = skip ? 64 : 72; pg8::Order S; S.init(nM, 1024, G, c, skip);
              pg8::Gemm gm{(const bf16_t*)(ws + WS_Y), (const bf16_t*)(ws + WS_WBR), 1536, 1024, 1536, 1536};
              EpiMerge E{(const bf16_t*)(ws + WS_ZG), (bf16_t*)(ws + WS_MB)}; pg8::gemm_phase(F.lds, gm, S, E, F.tid); }
            if (l_ == 0 && g_ == 1) { REFRESH(); (void)l; (void)g; (void)ws; phase_prep(F, 1, 0, 1864, 32, G - 32); }
            GSYNC();
            { REFRESH(); pg8::Order S; S.init(64, 1024, G, c, 1);
              pg8::Gemm gm{(const bf16_t*)(ws + WS_MB), (const bf16_t*)(ws + WS_WOUT), 1024, 1024, 1024, 1024};
              EpiRes E{l == 0 ? P.in[0] : P.out, P.out, l == 0 ? P.in[2] : (const float*)(ws + WS_CTXS), (float*)(ws + WS_CTXS), (const float*)(ws + WS_MOD) + (size_t)l * 17 * 6144, 2, g};
              pg8::gemm_phase(F.lds, gm, S, E, F.tid); }
            if (l_ == 0) for (int tk = c; tk < 128; tk += G) { REFRESH(); (void)l;
              const int un = tk >> 2, ks = tk & 3; pg8::OneUnit S{(un >> 2) * 9, un & 3, 1};
              pg8::Gemm gm{(const bf16_t*)(ws + WS_MB) + ks * 256, (const bf16_t*)(ws + WS_WOUT) + ks * 256, 1024, 1024, 256, 1024};
              EpiCtxPart E{(float*)(ws + WS_ZG), ks}; pg8::gemm_phase(F.lds, gm, S, E, F.tid); }
            GSYNC();
            REP(2) { REFRESH(); phase_norm(F, l, g, 1); }
            GSYNC();
            { REFRESH(); (void)g; const int skip = (l == 1); pg8::Order S; S.init(skip ? 64 : 72, 5632, G, c, skip);
              pg8::Gemm gm{(const bf16_t*)(ws + WS_H), (const bf16_t*)(ws + WS_WUP), 1024, 5632, 1024, 1024};
              EpiUpConv E{(bf16_t*)(ws + WS_HID), (bf16_t*)(ws + WS_EDGE), P.in[23] + (size_t)l * 3 * 5632, P.in[24] + (size_t)l * 5632}; pg8::gemm_phase(F.lds, gm, S, E, F.tid); }
            GSYNC();
            REP(2) { REFRESH(); (void)g; phase_ffedge(F, l); }
            GSYNC();
            { REFRESH(); pg8::Order S; S.init(64, 1024, G, c, 1);
              pg8::Gemm gm{(const bf16_t*)(ws + WS_HID), (const bf16_t*)(ws + WS_WDN), DFF, 1024, DFF, DFF};
              EpiRes E{P.out, P.out, (const float*)(ws + WS_CTXS), (float*)(ws + WS_CTXS), (const float*)(ws + WS_MOD) + (size_t)l * 17 * 6144, 5, g};
              pg8::gemm_phase(F.lds, gm, S, E, F.tid); }
            if (l_ == 0) for (int tk = c; tk < 256; tk += G) { REFRESH(); (void)l;
              const int un = tk >> 3, ks = tk & 7; const int k0 = ks < 6 ? ks * 384 : 2304 + (ks - 6) * 256, kl = ks < 6 ? 384 : 256;
              pg8::OneUnit S{(un >> 2) * 9, un & 3, 1};
              pg8::Gemm gm{(const bf16_t*)(ws + WS_HID) + k0, (const bf16_t*)(ws + WS_WDN) + k0, DFF, 1024, kl, DFF};
              EpiCtxPart E{(float*)(ws + WS_Z1), ks}; pg8::gemm_phase(F.lds, gm, S, E, F.tid); }
            if (g_ == 0) { const int gsave = 1; { int l = l_; int g = gsave; unsigned char* ws = P.ws; (void)ws; REFRESH_TID(); phase_norm(F, l, g, 0); } }
            GSYNC();
            if (l_ == 0) { { REFRESH(); (void)l; phase_ctxsum(F, g); } GSYNC(); }
        }
    }
    { const int l_ = 0, g_ = 0; REFRESH(); (void)l; (void)g; (void)ws; phase_final(F); }
}

extern "C" void kernel_launch(void* const* d_in, const int* in_sizes, int n_in, void* d_out, int out_size, void* d_ws, size_t ws_size, hipStream_t stream) {
    static int grid_blocks = 0;
    if (!grid_blocks) {
        int dev = 0, cus = 0, per_cu = 0;
        hipGetDevice(&dev);
        hipDeviceGetAttribute(&cus, hipDeviceAttributeMultiprocessorCount, dev);
        hipFuncSetAttribute((const void*)fwd_megakernel, hipFuncAttributeMaxDynamicSharedMemorySize, LDS_BYTES);
        hipOccupancyMaxActiveBlocksPerMultiprocessor(&per_cu, (const void*)fwd_megakernel, NTHREADS, LDS_BYTES);
        if (per_cu < 1) per_cu = 1;
        grid_blocks = cus * 1;
        if (ws_size < WS_END) fprintf(stderr, "kernel_launch: workspace too small: %zu < %zu\n", ws_size, (size_t)WS_END);
    }
    Params p{};
    for (int i = 0; i < 27; ++i) p.in[i] = (const float*)d_in[i];
    p.out = (float*)d_out; p.ws = (unsigned char*)d_ws;
    (void)hipMemsetAsync((unsigned char*)d_ws + WS_CNT, 0, 4096 + 16384, stream);
    void* args[] = {&p};
    hipError_t e = hipLaunchCooperativeKernel((const void*)fwd_megakernel, dim3(grid_blocks), dim3(NTHREADS), args, LDS_BYTES, stream);
    if (e != hipSuccess) fprintf(stderr, "cooperative launch failed: %s (grid %d)\n", hipGetErrorString(e), grid_blocks);
}
```

```cpp
#include <hip/hip_runtime.h>
#include <hip/hip_cooperative_groups.h>
#include <cstdio>
namespace cg = cooperative_groups;

#define LAS __attribute__((address_space(3)))
#define GAS __attribute__((address_space(1)))
typedef unsigned short bf16_t;
typedef short bf16x8 __attribute__((ext_vector_type(8)));
typedef float f32x4 __attribute__((ext_vector_type(4)));
typedef float f32x2 __attribute__((ext_vector_type(2)));
typedef unsigned u32x4 __attribute__((ext_vector_type(4)));
typedef unsigned u32x2 __attribute__((ext_vector_type(2)));

constexpr int DM = 1024, NB = 16, SEQ = 2048, CTXL = 256, SEQT = 2304;
constexpr int NGRP = 2, GB = 8, T = GB * SEQT;
constexpr int NZ1 = 3840, NZG = 3072, NIN = 6912;
constexpr int ZQ = 0, ZK = 512, ZV = 1024, ZO = 1536, ZCQ = 2048, ZCKV = 2432, ZKR = 2688, ZMG = 2752, ZU = 2816, ZS = 3328;
constexpr int DFF = 2816;
constexpr int NTHREADS = 512;
constexpr int LDS_BYTES = 155648;
constexpr float EPS = 1e-6f;
constexpr float QSCALE = 0.07216878364870322f * 1.4426950408889634f;

constexpr size_t WS_WIN = 0;
constexpr size_t WS_WUQ = WS_WIN + (size_t)NIN * 1024 * 2;
constexpr size_t WS_WUKV = WS_WUQ + (size_t)768 * 384 * 2;
constexpr size_t WS_WBR = WS_WUKV + (size_t)1024 * 256 * 2;
constexpr size_t WS_WOUT = WS_WBR + (size_t)3 * 1024 * 512 * 2;
constexpr size_t WS_WUP = WS_WOUT + (size_t)1024 * 1024 * 2;
constexpr size_t WS_WDN = WS_WUP + (size_t)5632 * 1024 * 2;
constexpr size_t WS_MOD = WS_WDN + (size_t)1024 * 2816 * 2;
constexpr size_t WS_ROPE = WS_MOD + (size_t)2 * 17 * 6144 * 4;
constexpr size_t WS_CNT = WS_ROPE + (size_t)2048 * 32 * 2 * 4;
constexpr size_t WS_BAR = WS_CNT + 4096;
constexpr size_t WS_CTXS = WS_BAR + 16384;
constexpr size_t WS_RS = WS_CTXS + (size_t)4096 * 1024 * 4;
constexpr size_t WS_H = WS_RS + (size_t)T * 2 * 4;
constexpr size_t WS_Z1 = WS_H + (size_t)T * 1024 * 2;
constexpr size_t WS_ZG = WS_Z1 + (size_t)T * NZ1 * 2;
constexpr size_t WS_QA = WS_ZG + (size_t)T * NZG * 2;
constexpr size_t WS_KV = WS_QA + (size_t)T * 768 * 2;
constexpr size_t WS_KR = WS_KV + (size_t)T * 1024 * 2;
constexpr size_t WS_HF = WS_KR + (size_t)T * 64 * 2;
constexpr size_t WS_HB = WS_HF + (size_t)T * 512 * 2;
constexpr size_t WS_Y = WS_HB + (size_t)T * 512 * 2;
constexpr size_t WS_EDGE = WS_Y + (size_t)T * 1536 * 2;
constexpr size_t WS_END = WS_EDGE + (size_t)72 * 16 * 5632 * 2;
constexpr size_t WS_M32 = WS_Z1;
constexpr size_t WS_MB = WS_Z1 + (size_t)T * 1024 * 4;
constexpr size_t WS_AUP = WS_Z1;
constexpr size_t WS_HID = WS_QA;
static_assert((size_t)T * 2816 * 2 <= (WS_EDGE - WS_QA), "HID alias");
static_assert((size_t)T * 1024 * 6 <= (size_t)T * NZ1 * 2, "M alias");
static_assert(WS_END <= (size_t)512 * 1024 * 1024, "workspace");

struct Params { const float* in[27]; float* out; unsigned char* ws; };
#ifndef PROBE
#define PROBE 0
#endif
#define REP(bit) for (int rep_ = 0; rep_ < (((PROBE) >> (bit)) & 1) + 1; ++rep_)

__device__ __forceinline__ unsigned pk2(float lo, float hi) { unsigned r; asm volatile("v_cvt_pk_bf16_f32 %0, %1, %2" : "=v"(r) : "v"(lo), "v"(hi)); return r; }
__device__ __forceinline__ float bflo(unsigned w) { return __uint_as_float(w << 16); }
__device__ __forceinline__ float bfhi(unsigned w) { return __uint_as_float(w & 0xffff0000u); }
__device__ __forceinline__ float bf2f(bf16_t h) { return __uint_as_float(((unsigned)h) << 16); }
__device__ __forceinline__ bf16_t f2bf(float f) { return (bf16_t)(pk2(f, 0.f) & 0xffffu); }
__device__ __forceinline__ float shx(float v, int o, int lane) { return __int_as_float(__builtin_amdgcn_ds_bpermute((lane ^ o) << 2, __float_as_int(v))); }
__device__ __forceinline__ float shi(float v, int src) { return __int_as_float(__builtin_amdgcn_ds_bpermute(src << 2, __float_as_int(v))); }
__device__ __forceinline__ float wave_sum(float v, int lane) {
    (void)lane;
    v += __int_as_float(__builtin_amdgcn_update_dpp(0, __float_as_int(v), 0xB1, 0xf, 0xf, false));
    v += __int_as_float(__builtin_amdgcn_update_dpp(0, __float_as_int(v), 0x4E, 0xf, 0xf, false));
    v += __int_as_float(__builtin_amdgcn_update_dpp(0, __float_as_int(v), 0x141, 0xf, 0xf, false));
    v += __int_as_float(__builtin_amdgcn_update_dpp(0, __float_as_int(v), 0x140, 0xf, 0xf, false));
    const float s0 = __int_as_float(__builtin_amdgcn_readlane(__float_as_int(v), 0)), s1 = __int_as_float(__builtin_amdgcn_readlane(__float_as_int(v), 16));
    const float s2 = __int_as_float(__builtin_amdgcn_readlane(__float_as_int(v), 32)), s3 = __int_as_float(__builtin_amdgcn_readlane(__float_as_int(v), 48));
    return (s0 + s1) + (s2 + s3);
}
__device__ __forceinline__ float sigmoidf_(float x) { return __builtin_amdgcn_rcpf(1.0f + __expf(-x)); }
__device__ __forceinline__ float siluf_(float x) { return x * __builtin_amdgcn_rcpf(1.0f + __expf(-x)); }
__device__ __forceinline__ float geluf_(float x) {
    const float y2 = -1.5957691216057308f * (x + 0.044715f * x * x * x);
    return x * __builtin_amdgcn_rcpf(1.0f + __expf(y2));
}
__device__ __forceinline__ float logsigmoidf_(float x) { return fminf(x, 0.f) - log1pf(__expf(-fabsf(x))); }
__device__ __forceinline__ f32x4 mfma16(bf16x8 a, bf16x8 b, f32x4 c) { return __builtin_amdgcn_mfma_f32_16x16x32_bf16(a, b, c, 0, 0, 0); }

namespace pg8 {
constexpr int BM = 256, BK = 64, HALF = 128, HTB = HALF * BK * 2, STAGE_BYTES = 8 * HTB, NXCD = 8, WGM = 8;
__device__ __forceinline__ int lds_byte(int r, int c) { const int st = (r >> 4) * 2 + (c >> 5), rr = r & 15, cc = c & 31, ob = rr * 64 + cc * 2; return st * 1024 + (ob ^ (((ob >> 9) & 1) << 5)); }
__device__ __forceinline__ void stage_rc(int b, int& R, int& C) { const int st = b / 1024, sb = b % 1024, swz = sb ^ (((sb >> 9) & 1) << 5); R = (st >> 1) * 16 + swz / 64; C = (st & 1) * 32 + (swz % 64) / 2; }
__device__ __forceinline__ int perm32(int rho) { const int n = rho >> 4, i = rho & 15; return 8 * (i >> 2) + 4 * n + (i & 3); }
struct Unit { int pm, pn; };
struct Gemm { const bf16_t* A; const bf16_t* Bt; int lda, N, K, ldb; };
struct Order {
    int nM, nN, nwg, G, c, skipctx;
    __device__ void init(int nM_, int N, int G_, int c_, int skip) { nM = nM_; nN = N / BM; nwg = nM * nN; G = G_; c = c_; skipctx = skip; }
    __device__ bool next(int i, Unit& u) const {
        const long L = (long)i * G + c; if (L >= nwg) return false;
        int wgid = (int)L; { const int q = nwg / NXCD, r = nwg % NXCD, xcd = wgid % NXCD, off = wgid / NXCD; wgid = (xcd < r ? xcd * (q + 1) : r * (q + 1) + (xcd - r) * q) + off; }
        const int nig = WGM * nN, gid = wgid / nig, fm = gid * WGM, gsz = (nM - fm) < WGM ? (nM - fm) : WGM;
        u.pm = fm + ((wgid % nig) % gsz); u.pn = (wgid % nig) / gsz;
        if (skipctx) u.pm = (u.pm >> 3) * 9 + 1 + (u.pm & 7);
        return true;
    }
};

struct OneUnit {
    int pm, pn, valid;
    __device__ bool next(int i, Unit& u) const { if (i != 0 || !valid) return false; u.pm = pm; u.pn = pn; return true; }
};

struct OrderL1In {
    Order base;
    __device__ bool next(int i, Unit& u) const {
        const long L = (long)i * base.G + base.c;
        if (L < base.nwg) return base.next(i, u);
        const int j = (int)(L - base.nwg); if (j >= 64) return false;
        const int q = j & 7; u.pm = (j >> 3) * 9; u.pn = q < 6 ? q : q + 3; return true;
    }
};

template <class Epi, class Ord>
__device__ __forceinline__ void gemm_phase(LAS unsigned char* lds, const Gemm g, const Ord& S, const Epi& E, int tid_in) {
    int tid = tid_in; asm volatile("" : "+v"(tid));
    const int wid = __builtin_amdgcn_readfirstlane(tid >> 6), lane = tid & 63, wr = wid >> 2, wc = wid & 3, fr = lane & 15, fq = lane >> 4;
    const int K = g.K, nt = K / BK;
    unsigned voffA[2], voffB[2];
#pragma unroll
    for (int i = 0; i < 2; ++i) { int R, C; stage_rc(tid * 16 + i * 8192, R, C); const int Rb = Epi::PERM ? ((R & ~31) + perm32(R & 31)) : R;
        voffA[i] = (unsigned)(R * g.lda + C) * 2u; voffB[i] = (unsigned)(Rb * g.ldb + C) * 2u; }
    const size_t kstep = (size_t)(BK * 2);
    const size_t hstepA = (size_t)HALF * g.lda * 2, hstepB = (size_t)HALF * g.ldb * 2;
    const size_t tstepA = 2 * hstepA, tstepB = 2 * hstepB;
    const unsigned ldsw = (unsigned)wid * 1024u;
    const int aoff = lds_byte(wr * 64 + fr, fq * 8), boff = lds_byte(wc * 32 + fr, fq * 8);
#define PG8_SA(b, h) (((b) * 2 + (h)) * HTB)
#define PG8_SB(b, h) ((4 + (b) * 2 + (h)) * HTB)
#define PG8_STAGE(bufoff, gbase, voff) do { _Pragma("unroll") for (int _i = 0; _i < 2; ++_i) \
        __builtin_amdgcn_global_load_lds((const GAS unsigned*)((const char*)(gbase) + (voff)[_i]), (LAS unsigned*)(lds + (bufoff) + ldsw + _i * 8192), 16, 0, 0); } while (0)
#define PG8_LDA(dst, b, h) do { _Pragma("unroll") for (int m = 0; m < 4; ++m) _Pragma("unroll") for (int k = 0; k < 2; ++k) dst[m][k] = *(const LAS bf16x8*)(lds + PG8_SA(b, h) + aoff + m * 2048 + k * 1024); } while (0)
#define PG8_LDB(dst, b, h) do { _Pragma("unroll") for (int n = 0; n < 2; ++n) _Pragma("unroll") for (int k = 0; k < 2; ++k) dst[n][k] = *(const LAS bf16x8*)(lds + PG8_SB(b, h) + boff + n * 2048 + k * 1024); } while (0)
#define PG8_MMA(ai, bj, At, Bt) do { __builtin_amdgcn_s_setprio(1); _Pragma("unroll") for (int m = 0; m < 4; ++m) _Pragma("unroll") for (int n = 0; n < 2; ++n) _Pragma("unroll") for (int k = 0; k < 2; ++k) \
        acc[ai][bj][m][n] = __builtin_amdgcn_mfma_f32_16x16x32_bf16(Bt[n][k], At[m][k], acc[ai][bj][m][n], 0, 0, 0); __builtin_amdgcn_s_setprio(0); } while (0)
#define PG8_WAIT_V(n) asm volatile("s_waitcnt vmcnt(" #n ")" ::: "memory")
#define PG8_WAIT_L(n) asm volatile("s_waitcnt lgkmcnt(" #n ")" ::: "memory")
#define PG8_BAR __builtin_amdgcn_s_barrier()
#define PG8_SCHED __builtin_amdgcn_sched_barrier(0)
    Unit cur, nxt; int ui = 0;
    if (!S.next(0, cur)) return;
    f32x4 acc[2][2][4][2];
#pragma unroll
    for (int a = 0; a < 2; ++a)
#pragma unroll
        for (int b = 0; b < 2; ++b)
#pragma unroll
            for (int m = 0; m < 4; ++m)
#pragma unroll
                for (int n = 0; n < 2; ++n) acc[a][b][m][n] = (f32x4){0.f, 0.f, 0.f, 0.f};
    bf16x8 At[4][2], B0[2][2], B1[2][2];
    const char* cA = (const char*)g.A + (size_t)cur.pm * tstepA; const char* cB = (const char*)g.Bt + (size_t)cur.pn * tstepB;
    PG8_STAGE(PG8_SB(0, 0), cB, voffB); PG8_STAGE(PG8_SA(0, 0), cA, voffA); PG8_STAGE(PG8_SB(0, 1), cB + hstepB, voffB); PG8_STAGE(PG8_SA(0, 1), cA + hstepA, voffA);
    if (wr == 1) PG8_BAR;
    PG8_WAIT_V(4); PG8_BAR;
    PG8_STAGE(PG8_SB(1, 0), cB + kstep, voffB); PG8_STAGE(PG8_SA(1, 0), cA + kstep, voffA); PG8_STAGE(PG8_SB(1, 1), cB + hstepB + kstep, voffB);
    PG8_WAIT_V(6); PG8_BAR;
    for (;;) {
        const bool has_next = S.next(ui + 1, nxt);
        const char* nA = has_next ? (const char*)g.A + (size_t)nxt.pm * tstepA : cA; const char* nB = has_next ? (const char*)g.Bt + (size_t)nxt.pn * tstepB : cB;
        for (int t = 0; t < nt; t += 2) {
            const bool last = (t == nt - 2);
            const char* a1 = cA + (size_t)(t + 1) * kstep;
            const char* a2 = last ? nA : cA + (size_t)(t + 2) * kstep; const char* b2 = last ? nB : cB + (size_t)(t + 2) * kstep;
            const char* a3 = a2 + kstep; const char* b3 = b2 + kstep;
            if constexpr (Epi::RESCALE) { if (t == 8 || t == 16) { int ln_; asm volatile("v_mbcnt_lo_u32_b32 %0, -1, 0\n\tv_mbcnt_hi_u32_b32 %0, -1, %0" : "=v"(ln_)); E.rescale(acc, cur, t >> 4, wr, wc, ln_ & 15, ln_ >> 4); } }
            PG8_LDB(B0, 0, 0); PG8_SCHED; PG8_LDA(At, 0, 0); PG8_STAGE(PG8_SA(1, 1), a1 + hstepA, voffA);
            PG8_WAIT_L(8); PG8_BAR; PG8_WAIT_L(0); PG8_MMA(0, 0, At, B0); PG8_BAR; PG8_SCHED;
            PG8_LDB(B1, 0, 1); PG8_STAGE(PG8_SB(0, 0), b2, voffB);
            PG8_BAR; PG8_WAIT_L(0); PG8_MMA(0, 1, At, B1); PG8_BAR;
            PG8_LDA(At, 0, 1); PG8_STAGE(PG8_SA(0, 0), a2, voffA);
            PG8_BAR; PG8_WAIT_L(0); PG8_MMA(1, 0, At, B0); PG8_BAR; PG8_SCHED;
            PG8_STAGE(PG8_SB(0, 1), b2 + hstepB, voffB);
            PG8_WAIT_V(6); PG8_BAR; PG8_MMA(1, 1, At, B1); PG8_BAR;
            PG8_LDB(B0, 1, 0); PG8_SCHED; PG8_LDA(At, 1, 0); PG8_STAGE(PG8_SA(0, 1), a2 + hstepA, voffA);
            PG8_WAIT_L(8); PG8_BAR; PG8_WAIT_L(0); PG8_MMA(0, 0, At, B0); PG8_BAR; PG8_SCHED;
            PG8_LDB(B1, 1, 1); PG8_STAGE(PG8_SB(1, 0), b3, voffB);
            PG8_BAR; PG8_WAIT_L(0); PG8_MMA(0, 1, At, B1); PG8_BAR;
            PG8_LDA(At, 1, 1); PG8_STAGE(PG8_SA(1, 0), a3, voffA);
            PG8_BAR; PG8_WAIT_L(0); PG8_MMA(1, 0, At, B0); PG8_BAR; PG8_SCHED;
            PG8_STAGE(PG8_SB(1, 1), b3 + hstepB, voffB);
            PG8_WAIT_V(6); PG8_BAR; PG8_MMA(1, 1, At, B1); PG8_BAR;
        }
        { int ln_; asm volatile("v_mbcnt_lo_u32_b32 %0, -1, 0\n\tv_mbcnt_hi_u32_b32 %0, -1, %0" : "=v"(ln_)); E(acc, cur, wr, wc, ln_ & 15, ln_ >> 4); }
        if (!has_next) break;
#pragma unroll
        for (int a = 0; a < 2; ++a)
#pragma unroll
            for (int b = 0; b < 2; ++b)
#pragma unroll
                for (int m = 0; m < 4; ++m)
#pragma unroll
                    for (int n = 0; n < 2; ++n) acc[a][b][m][n] = (f32x4){0.f, 0.f, 0.f, 0.f};
        cur = nxt; cA = nA; cB = nB; ++ui;
    }
    PG8_WAIT_V(0);
    if (wr == 0) PG8_BAR;
    PG8_BAR;
#undef PG8_SA
#undef PG8_SB
#undef PG8_STAGE
#undef PG8_LDA
#undef PG8_LDB
#undef PG8_MMA
#undef PG8_WAIT_V
#undef PG8_WAIT_L
#undef PG8_BAR
#undef PG8_SCHED
}
}

typedef const f32x4 (&AccRef)[2][2][4][2];

struct EpiIn {
    static constexpr bool PERM = true, RESCALE = false;
    bf16_t* Z1; bf16_t* ZG;
    __device__ __forceinline__ void operator()(AccRef acc, const pg8::Unit& u, int wr, int wc, int fr, int fq) const {
        asm volatile("" : "+v"(fr), "+v"(fq));
        bf16_t* base; int ld;
        if (u.pn < 15) { base = Z1 + u.pn * 256; ld = NZ1; } else { base = ZG + (u.pn - 15) * 256; ld = NZG; }
        const int row0 = u.pm * 256 + wr * 64 + fr, col0 = wc * 32 + 8 * fq;
#pragma unroll
        for (int ai = 0; ai < 2; ++ai)
#pragma unroll
            for (int m = 0; m < 4; ++m) { bf16_t* rowp = base + (size_t)(row0 + ai * 128 + m * 16) * ld + col0;
#pragma unroll
                for (int bj = 0; bj < 2; ++bj) { const f32x4 v0 = acc[ai][bj][m][0], v1 = acc[ai][bj][m][1];
                    u32x4 w; w.x = pk2(v0[0], v0[1]); w.y = pk2(v0[2], v0[3]); w.z = pk2(v1[0], v1[1]); w.w = pk2(v1[2], v1[3]);
                    *(GAS u32x4*)(rowp + bj * 128) = w; } }
    }
};
struct EpiBf {
    static constexpr bool PERM = true, RESCALE = false;
    bf16_t* O; int ld; const float* rs;
    __device__ __forceinline__ void operator()(AccRef acc, const pg8::Unit& u, int wr, int wc, int fr, int fq) const {
        asm volatile("" : "+v"(fr), "+v"(fq));
        const int row0 = u.pm * 256 + wr * 64 + fr, col0 = u.pn * 256 + wc * 32 + 8 * fq;
#pragma unroll
        for (int ai = 0; ai < 2; ++ai)
#pragma unroll
            for (int m = 0; m < 4; ++m) { const int row = row0 + ai * 128 + m * 16; bf16_t* rowp = O + (size_t)row * ld + col0;
                const float s = rs ? ((const GAS float*)rs)[row * 2] : 1.0f;
#pragma unroll
                for (int bj = 0; bj < 2; ++bj) { const f32x4 v0 = acc[ai][bj][m][0] * s, v1 = acc[ai][bj][m][1] * s;
                    u32x4 w; w.x = pk2(v0[0], v0[1]); w.y = pk2(v0[2], v0[3]); w.z = pk2(v1[0], v1[1]); w.w = pk2(v1[2], v1[3]);
                    *(GAS u32x4*)(rowp + bj * 128) = w; } }
    }
};
struct EpiVT {
    static constexpr bool PERM = true, RESCALE = false;
    bf16_t* O; const float* rs;
    __device__ __forceinline__ void operator()(AccRef acc, const pg8::Unit& u, int wr, int wc, int fr, int fq) const {
        asm volatile("" : "+v"(fr), "+v"(fq));
        const int bl = u.pn / 9, p0 = (u.pn % 9) * 256;
        const int f0 = u.pm * 256 + wr * 64 + fr;
#pragma unroll
        for (int bj = 0; bj < 2; ++bj)
#pragma unroll
            for (int n = 0; n < 2; ++n) { const int cl = bj * 128 + wc * 32 + 8 * fq + 4 * n;
                const GAS float* rp = (const GAS float*)(rs + (size_t)(u.pn * 256 + cl) * 2);
                const float s0 = rp[0], s1 = rp[2], s2 = rp[4], s3 = rp[6];
                const int pos = (cl & ~31) + ((cl >> 2) & 3) * 8 + ((cl >> 4) & 1) * 4;
#pragma unroll
                for (int ai = 0; ai < 2; ++ai)
#pragma unroll
                    for (int m = 0; m < 4; ++m) { const int f = f0 + ai * 128 + m * 16; const int hh = f >> 7, e = f & 127;
                        const f32x4 v = acc[ai][bj][m][n];
                        u32x2 w; w.x = pk2(v[0] * s0, v[1] * s1); w.y = pk2(v[2] * s2, v[3] * s3);
                        *(GAS u32x2*)(O + ((size_t)((bl * 4 + hh) * 128 + e)) * SEQT + p0 + pos) = w; }
                asm volatile("" ::: "memory"); }
    }
};
struct EpiQ {
    static constexpr bool PERM = false, RESCALE = false;
    bf16_t* O; const float* rs; const float* rope;
    __device__ __forceinline__ void operator()(AccRef acc, const pg8::Unit& u, int wr, int wc, int fr, int fq) const {
        asm volatile("" : "+v"(fr), "+v"(fq));
        const int row0 = u.pm * 256 + wr * 64 + fr;
        const bool lat = (u.pm % 9) != 0;
        const int posb = ((u.pm % 9) - 1) * 256 + wr * 64 + fr;
#pragma unroll
        for (int ai = 0; ai < 2; ++ai)
#pragma unroll
            for (int m = 0; m < 4; ++m) { const int row = row0 + ai * 128 + m * 16; const int pos = posb + ai * 128 + m * 16;
                const float s = ((const GAS float*)rs)[row * 2] * QSCALE;
#pragma unroll
                for (int bj = 0; bj < 2; ++bj)
#pragma unroll
                    for (int n = 0; n < 2; ++n) { const int c0 = u.pn * 256 + bj * 128 + wc * 32 + 16 * n + 4 * fq; const int within = c0 % 192;
                        f32x4 v0 = acc[ai][bj][m][n] * s;
                        if (lat && within >= 128) { const int i0 = (within - 128) >> 1; const f32x4 r0 = *(const GAS f32x4*)(rope + ((size_t)pos * 32 + i0) * 2);
                            float a, b;
                            a = v0[0] * r0[0] - v0[1] * r0[1]; b = v0[0] * r0[1] + v0[1] * r0[0]; v0[0] = a; v0[1] = b;
                            a = v0[2] * r0[2] - v0[3] * r0[3]; b = v0[2] * r0[3] + v0[3] * r0[2]; v0[2] = a; v0[3] = b; }
                        u32x2 w; w.x = pk2(v0[0], v0[1]); w.y = pk2(v0[2], v0[3]);
                        *(GAS u32x2*)(O + (size_t)row * 768 + c0) = w; }
                asm volatile("" ::: "memory"); }
    }
};
struct EpiMerge {
    static constexpr bool PERM = false, RESCALE = true;
    const bf16_t* ZG; bf16_t* MB;
    __device__ __forceinline__ void rescale(f32x4 (&acc)[2][2][4][2], const pg8::Unit& u, int seg, int wr, int wc, int fr, int fq) const {
        const int row0 = u.pm * 256 + wr * 64 + fr, col0 = u.pn * 256 + wc * 32 + 4 * fq;
#pragma unroll
        for (int ai = 0; ai < 2; ++ai)
#pragma unroll
            for (int m = 0; m < 4; ++m) { const bf16_t* zr = ZG + (size_t)(row0 + ai * 128 + m * 16) * NZG + seg * 1024 + col0;
#pragma unroll
                for (int bj = 0; bj < 2; ++bj)
#pragma unroll
                    for (int n = 0; n < 2; ++n) { const u32x2 ga = *(const GAS u32x2*)(zr + bj * 128 + n * 16), gb = *(const GAS u32x2*)(zr + 1024 + bj * 128 + n * 16);
                        f32x4 r;
                        r[0] = (1.0f + __expf(-bflo(gb.x))) * __builtin_amdgcn_rcpf(1.0f + __expf(-bflo(ga.x)));
                        r[1] = (1.0f + __expf(-bfhi(gb.x))) * __builtin_amdgcn_rcpf(1.0f + __expf(-bfhi(ga.x)));
                        r[2] = (1.0f + __expf(-bflo(gb.y))) * __builtin_amdgcn_rcpf(1.0f + __expf(-bflo(ga.y)));
                        r[3] = (1.0f + __expf(-bfhi(gb.y))) * __builtin_amdgcn_rcpf(1.0f + __expf(-bfhi(ga.y)));
                        acc[ai][bj][m][n] *= r; }
                asm volatile("" ::: "memory"); }
    }
    __device__ __forceinline__ void operator()(AccRef acc, const pg8::Unit& u, int wr, int wc, int fr, int fq) const {
        asm volatile("" : "+v"(fr), "+v"(fq));
        const int row0 = u.pm * 256 + wr * 64 + fr, col0 = u.pn * 256 + wc * 32 + 4 * fq;
#pragma unroll
        for (int ai = 0; ai < 2; ++ai)
#pragma unroll
            for (int m = 0; m < 4; ++m) { const int row = row0 + ai * 128 + m * 16;
#pragma unroll
                for (int bj = 0; bj < 2; ++bj)
#pragma unroll
                    for (int n = 0; n < 2; ++n) { const int c = col0 + bj * 128 + n * 16;
                        const u32x2 gw = *(const GAS u32x2*)(ZG + (size_t)row * NZG + 2 * 1024 + c);
                        f32x4 gt; gt[0] = sigmoidf_(bflo(gw.x)); gt[1] = sigmoidf_(bfhi(gw.x)); gt[2] = sigmoidf_(bflo(gw.y)); gt[3] = sigmoidf_(bfhi(gw.y));
                        const f32x4 v = gt * acc[ai][bj][m][n];
                        u32x2 w; w.x = pk2(v[0], v[1]); w.y = pk2(v[2], v[3]); *(GAS u32x2*)(MB + (size_t)row * 1024 + c) = w; } }
    }
};
__device__ __forceinline__ float dpp_ror1(float v) { return __int_as_float(__builtin_amdgcn_update_dpp(0, __float_as_int(v), 0x121, 0xf, 0xf, false)); }
__device__ __forceinline__ float dpp_ror15(float v) { return __int_as_float(__builtin_amdgcn_update_dpp(0, __float_as_int(v), 0x12f, 0xf, 0xf, false)); }
struct EpiUpConv {
    static constexpr bool PERM = true, RESCALE = false;
    bf16_t* HID; bf16_t* EDGE; const float* wc; const float* bc;
    __device__ __forceinline__ void operator()(AccRef acc, const pg8::Unit& u, int wr, int wc_, int fr, int fq) const {
        asm volatile("" : "+v"(fr), "+v"(fq));
        const int ch0 = u.pn * 128 + wc_ * 32 + 8 * fq;
#pragma unroll
        for (int n = 0; n < 2; ++n) {
            int fq2 = fq; asm volatile("" : "+v"(fq2));
            const int ch = u.pn * 128 + wc_ * 32 + 8 * fq2 + 4 * n; (void)ch0;
            const f32x4 wg0 = *(const GAS f32x4*)(wc + ch), wg1 = *(const GAS f32x4*)(wc + 5632 + ch), wg2 = *(const GAS f32x4*)(wc + 2 * 5632 + ch), bg = *(const GAS f32x4*)(bc + ch);
            const f32x4 wv0 = *(const GAS f32x4*)(wc + DFF + ch), wv1 = *(const GAS f32x4*)(wc + 5632 + DFF + ch), wv2 = *(const GAS f32x4*)(wc + 2 * 5632 + DFF + ch), bv = *(const GAS f32x4*)(bc + DFF + ch);
#pragma unroll
            for (int ai = 0; ai < 2; ++ai) {
                const int blk = ai * 2 + wr; const int rowb = u.pm * 256 + blk * 64;
                bf16_t* eg = EDGE + ((size_t)(u.pm * 4 + blk) * 4) * 5632 + ch;
                if (fr < 2) { const f32x4 g = acc[ai][0][0][n], v = acc[ai][1][0][n]; u32x2 a, b; a.x = pk2(g[0], g[1]); a.y = pk2(g[2], g[3]); b.x = pk2(v[0], v[1]); b.y = pk2(v[2], v[3]);
                    *(GAS u32x2*)(eg + (size_t)fr * 5632) = a; *(GAS u32x2*)(eg + (size_t)fr * 5632 + DFF) = b; }
                if (fr >= 14) { const f32x4 g = acc[ai][0][3][n], v = acc[ai][1][3][n]; u32x2 a, b; a.x = pk2(g[0], g[1]); a.y = pk2(g[2], g[3]); b.x = pk2(v[0], v[1]); b.y = pk2(v[2], v[3]);
                    *(GAS u32x2*)(eg + (size_t)(fr - 12) * 5632) = a; *(GAS u32x2*)(eg + (size_t)(fr - 12) * 5632 + DFF) = b; }
#pragma unroll
                for (int m = 0; m < 4; ++m) {
                    f32x4 o;
#pragma unroll
                    for (int j = 0; j < 4; ++j) {
                        const float gc = acc[ai][0][m][n][j], vc = acc[ai][1][m][n][j];
                        const float gpa = dpp_ror1(gc), gpb = dpp_ror1(acc[ai][0][m > 0 ? m - 1 : 0][n][j]), gna = dpp_ror15(gc), gnb = dpp_ror15(acc[ai][0][m < 3 ? m + 1 : 3][n][j]);
                        const float vpa = dpp_ror1(vc), vpb = dpp_ror1(acc[ai][1][m > 0 ? m - 1 : 0][n][j]), vna = dpp_ror15(vc), vnb = dpp_ror15(acc[ai][1][m < 3 ? m + 1 : 3][n][j]);
                        const float gp = fr == 0 ? gpb : gpa, gn = fr == 15 ? gnb : gna, vp = fr == 0 ? vpb : vpa, vn = fr == 15 ? vnb : vna;
                        const float cg = bg[j] + wg0[j] * gp + wg1[j] * gc + wg2[j] * gn;
                        const float cv = bv[j] + wv0[j] * vp + wv1[j] * vc + wv2[j] * vn;
                        o[j] = siluf_(cg) * cv;
                    }
                    const bool seam = (m == 0 && fr == 0) || (m == 3 && fr == 15);
                    if (!seam) { u32x2 w; w.x = pk2(o[0], o[1]); w.y = pk2(o[2], o[3]); *(GAS u32x2*)(HID + (size_t)(rowb + m * 16 + fr) * DFF + ch) = w; }
                }
            }
        }
    }
};
struct EpiCtxPart {
    static constexpr bool PERM = false, RESCALE = false;
    float* pb; int ks;
    __device__ __forceinline__ void operator()(AccRef acc, const pg8::Unit& u, int wr, int wc, int fr, int fq) const {
        asm volatile("" : "+v"(fr), "+v"(fq));
        const int bl = u.pm / 9;
        float* dst = pb + ((size_t)ks * (GB * CTXL) + bl * CTXL) * DM;
        const int r0 = wr * 64 + fr, col0 = u.pn * 256 + wc * 32 + 4 * fq;
#pragma unroll
        for (int ai = 0; ai < 2; ++ai)
#pragma unroll
            for (int m = 0; m < 4; ++m)
#pragma unroll
                for (int bj = 0; bj < 2; ++bj)
#pragma unroll
                    for (int n = 0; n < 2; ++n) *(GAS f32x4*)(dst + (size_t)(r0 + ai * 128 + m * 16) * DM + col0 + bj * 128 + n * 16) = acc[ai][bj][m][n];
    }
};
struct EpiRes {
    static constexpr bool PERM = false, RESCALE = false;
    const float* xsrc; float* xdst; const float* csrc; float* cdst; const float* mod; int mi; int grp;
    __device__ __forceinline__ void operator()(AccRef acc, const pg8::Unit& u, int wr, int wc, int fr, int fq) const {
        asm volatile("" : "+v"(fr), "+v"(fq));
        const int bl = u.pm / 9, j = u.pm % 9, b = grp * GB + bl;
        const float* src; float* dst; int mrow;
        if (j == 0) { src = csrc + (size_t)b * CTXL * DM; dst = cdst + (size_t)b * CTXL * DM; mrow = 16; }
        else { const size_t o = ((size_t)b * SEQ + (j - 1) * 256) * DM; src = xsrc + o; dst = xdst + o; mrow = b; }
        const float* mv = mod + mrow * 6144 + mi * 1024;
        const int r0 = wr * 64 + fr, col0 = u.pn * 256 + wc * 32 + 4 * fq;
        f32x4 mg[2][2];
#pragma unroll
        for (int bj = 0; bj < 2; ++bj)
#pragma unroll
            for (int n = 0; n < 2; ++n) mg[bj][n] = *(const GAS f32x4*)(mv + col0 + bj * 128 + n * 16);
#pragma unroll
        for (int ai = 0; ai < 2; ++ai)
#pragma unroll
            for (int m = 0; m < 4; ++m) { const size_t ro = (size_t)(r0 + ai * 128 + m * 16) * DM + col0;
#pragma unroll
                for (int bj = 0; bj < 2; ++bj)
#pragma unroll
                    for (int n = 0; n < 2; ++n) { const f32x4 xo = *(const GAS f32x4*)(src + ro + bj * 128 + n * 16);
                        *(GAS f32x4*)(dst + ro + bj * 128 + n * 16) = xo + mg[bj][n] * acc[ai][bj][m][n]; } }
    }
};

#define XB_TMO      128
#define XB_XCNT(j)  (256  + 64 * (j))
#define XB_XSUB(j)  (1280 + 64 * (j))
#define XB_XGEN(j)  (2304 + 64 * (j))
#define XB_TOP      3328
#define XB_TOPGEN   3392
#define XCD_BAR_WORDS 3456
#define XB_SPIN_CAP (1u << 20)
__device__ __forceinline__ unsigned xb_ld(unsigned* p)              { return __hip_atomic_load(p, __ATOMIC_RELAXED, __HIP_MEMORY_SCOPE_AGENT); }
__device__ __forceinline__ unsigned xb_add(unsigned* p, unsigned v) { return __hip_atomic_fetch_add(p, v, __ATOMIC_RELAXED, __HIP_MEMORY_SCOPE_AGENT); }
__device__ __forceinline__ unsigned xb_xcc_id() { return (unsigned)__builtin_amdgcn_s_getreg((3 << 11) | 20) & 0xFu; }
#define XB_SPIN(cond, bar) do { unsigned _sp = 0; while (cond) { __builtin_amdgcn_s_sleep(1); \
    if ((++_sp & 255u) == 0u) { if (xb_ld(&(bar)[XB_TMO])) break; if (_sp > XB_SPIN_CAP) { xb_add(&(bar)[XB_TMO], 1u); break; } } } } while (0)
__device__ __forceinline__ void xcd_barrier_complete(unsigned* bar, unsigned x, unsigned& nloc, unsigned& nx) {
    const unsigned G = gridDim.x;
    unsigned sum, cnt, mine, sp = 0u;
    for (;;) {
        sum = 0u; cnt = 0u; mine = 0u;
#pragma unroll
        for (unsigned j = 0; j < 16; ++j) { const unsigned c = xb_ld(&bar[XB_XCNT(j)]); sum += c; cnt += (c > 0u) ? 1u : 0u; mine = (j == x) ? c : mine; }
        if (sum == G) break;
        __builtin_amdgcn_s_sleep(1);
        if ((++sp & 255u) == 0u) { if (xb_ld(&bar[XB_TMO])) break; if (sp > XB_SPIN_CAP) { xb_add(&bar[XB_TMO], 1u); break; } }
    }
    nloc = mine > 0u ? mine : 1u; nx = cnt > 0u ? cnt : 1u;
}
__device__ __forceinline__ void xcd_barrier(unsigned* bar, volatile LAS unsigned* st, bool leader) {
    asm volatile("s_waitcnt vmcnt(0)" ::: "memory");
    __syncthreads();
    if (leader) {
        __builtin_amdgcn_s_waitcnt(0);
        const unsigned x = xb_xcc_id();
        unsigned nloc = st[0], nx = st[1];
        if (nloc == 0u) { xcd_barrier_complete(bar, x, nloc, nx); st[0] = nloc; st[1] = nx; }
        const unsigned old = xb_add(&bar[XB_XSUB(x)], 1u);
        const unsigned gen = old / nloc;
        if (old + 1u == (gen + 1u) * nloc) {
            __builtin_amdgcn_fence(__ATOMIC_RELEASE, "agent");
            asm volatile("s_waitcnt vmcnt(0)" ::: "memory");
            const unsigned og = xb_add(&bar[XB_TOP], 1u);
            const unsigned tg = og / nx;
            if (og + 1u == (tg + 1u) * nx) xb_add(&bar[XB_TOPGEN], 1u);
            else XB_SPIN(xb_ld(&bar[XB_TOPGEN]) == tg, bar);
            __builtin_amdgcn_fence(__ATOMIC_ACQUIRE, "agent");
            xb_add(&bar[XB_XGEN(x)], 1u);
            asm volatile("s_waitcnt vmcnt(0)" ::: "memory");
        } else {
            XB_SPIN(xb_ld(&bar[XB_XGEN(x)]) == gen, bar);
            __builtin_amdgcn_fence(__ATOMIC_ACQUIRE, "agent");
            asm volatile("s_waitcnt vmcnt(0)" ::: "memory");
        }
    }
    __syncthreads();
}

struct Ctx {
    LAS unsigned char* lds; int tid, lane, wave;
    const Params* P; unsigned char* ws;
};

__device__ __forceinline__ int inmap(int n) {
    if (n < 2048) return n;
    if (n < 2432) return 2064 + (n - 2048);
    if (n < 2688) return 2448 + (n - 2432);
    if (n < 2752) return 2704 + (n - 2688);
    if (n < 2768) return 2048 + (n - 2752);
    if (n < 2816) return -1;
    if (n < 3328) return 2768 + (n - 2816);
    if (n < 3840) return 3280 + (n - 3328);
    return 3792 + (n - 3840);
}

__device__ __forceinline__ void wprep_tile(const Ctx& F, const float* W, int ldw, int K, bf16_t* Bt, int n0, int k0, int isin, const float* kscale, int ldb = 0) {
    if (ldb == 0) ldb = K;
    LAS float* tile = (LAS float*)F.lds;
    const int t = F.tid;
    const int nn = t & 63, kb = t >> 6;
    const int nq = n0 + nn;
    const int sc = isin == 1 ? inmap(nq) : isin == 2 ? (((nq & 511) >> 7) * 256 + (nq >> 9) * 128 + (nq & 127)) : isin == 3 ? (((nq >> 7) & 1) * DFF + (nq >> 8) * 128 + (nq & 127)) : nq;
#pragma unroll
    for (int i = 0; i < 8; ++i) { const int kk = i * 8 + kb; float v = sc >= 0 ? W[(size_t)(k0 + kk) * ldw + sc] : 0.f; if (kscale) v *= kscale[k0 + kk]; tile[kk * 65 + nn] = v; }
    __syncthreads();
    const int n = t >> 3, c = t & 7;
    const LAS float* s = tile + (8 * c) * 65 + n;
    u32x4 o; o.x = pk2(s[0], s[65]); o.y = pk2(s[130], s[195]); o.z = pk2(s[260], s[325]); o.w = pk2(s[390], s[455]);
    *(GAS u32x4*)(Bt + (size_t)(n0 + n) * ldb + k0 + 8 * c) = o;
}

__device__ __forceinline__ void phase_prep(const Ctx& F, int l) {
    const Params& P = *F.P; unsigned char* ws = F.ws;
    const int NWT = 1728 + 72 + 64 + 384 + 256 + 1408 + 704;
    const int total = NWT + (l == 0 ? 192 + 128 : 0);
    for (int it0 = blockIdx.x; it0 < total; it0 += gridDim.x) {
        __syncthreads();
        int it = it0;
        if (it < NWT) {
            if (it < 1728) { wprep_tile(F, P.in[7] + (size_t)l * 1024 * 6864, 6864, 1024, (bf16_t*)(ws + WS_WIN), (it / 16) * 64, (it % 16) * 64, 1, nullptr); continue; } it -= 1728;
            if (it < 72) { wprep_tile(F, P.in[13] + (size_t)l * 384 * 768, 768, 384, (bf16_t*)(ws + WS_WUQ), (it / 6) * 64, (it % 6) * 64, 0, P.in[12] + l * 384); continue; } it -= 72;
            if (it < 64) { wprep_tile(F, P.in[15] + (size_t)l * 256 * 1024, 1024, 256, (bf16_t*)(ws + WS_WUKV), (it / 4) * 64, (it % 4) * 64, 2, P.in[14] + l * 256); continue; } it -= 64;
            if (it < 384) { const int gb = it / 128, r = it % 128; wprep_tile(F, P.in[19] + ((size_t)l * 3 + gb) * 512 * 1024, 1024, 512, (bf16_t*)(ws + WS_WBR) + (size_t)gb * 512, (r / 8) * 64, (r % 8) * 64, 0, nullptr, 1536); continue; } it -= 384;
            if (it < 256) { wprep_tile(F, P.in[20] + (size_t)l * 1024 * 1024, 1024, 1024, (bf16_t*)(ws + WS_WOUT), (it / 16) * 64, (it % 16) * 64, 0, nullptr); continue; } it -= 256;
            if (it < 1408) { wprep_tile(F, P.in[22] + (size_t)l * 1024 * 5632, 5632, 1024, (bf16_t*)(ws + WS_WUP), (it / 16) * 64, (it % 16) * 64, 3, nullptr); continue; } it -= 1408;
            wprep_tile(F, P.in[25] + (size_t)l * 2816 * 1024, 1024, 2816, (bf16_t*)(ws + WS_WDN), (it / 44) * 64, (it % 44) * 64, 0, nullptr); continue;
        }
        it -= NWT;
        if (it < 192) {
            const int l2 = it / 96, nb = it % 96;
            LAS float* cond = (LAS float*)F.lds; LAS float* red = cond + 17 * 1024;
            for (int i = F.tid; i < 17 * 1024; i += NTHREADS) { const int r = i >> 10, k = i & 1023; const float cv = r < 16 ? P.in[1][r * 1024 + k] : P.in[3][k]; cond[i] = siluf_(cv); }
            __syncthreads();
            const int cc = F.tid & 63, ks = F.tid >> 6; const int col = nb * 64 + cc;
            const float* wa = P.in[4] + (size_t)l2 * 1024 * 6144 + col;
            float a[17];
#pragma unroll
            for (int r = 0; r < 17; ++r) a[r] = 0.f;
            for (int k = ks * 128; k < ks * 128 + 128; ++k) { const float w = wa[(size_t)k * 6144];
#pragma unroll
                for (int r = 0; r < 17; ++r) a[r] += cond[r * 1024 + k] * w; }
#pragma unroll
            for (int r = 0; r < 17; ++r) red[(ks * 17 + r) * 64 + cc] = a[r];
            __syncthreads();
            for (int i = F.tid; i < 17 * 64; i += NTHREADS) { const int r = i >> 6, c2 = i & 63; float s = P.in[5][l2 * 6144 + nb * 64 + c2];
#pragma unroll
                for (int q = 0; q < 8; ++q) s += red[(q * 17 + r) * 64 + c2];
                ((float*)(ws + WS_MOD))[((size_t)l2 * 17 + r) * 6144 + nb * 64 + c2] = s; }
            continue;
        }
        it -= 192;
        {
            const int e = it * NTHREADS + F.tid; const int pos = e >> 5, i = e & 31;
            const float inv = exp2f(-(float)(i & 15) * (13.287712379549449f / 16.0f));
            const float ang = (float)(i < 16 ? (pos >> 6) : (pos & 63)) * inv;
            f32x2 cs; cs.x = cosf(ang); cs.y = sinf(ang);
            ((GAS f32x2*)(ws + WS_ROPE))[e] = cs;
        }
    }
}

__device__ __forceinline__ void phase_norm(const Ctx& F, int l, int g, int which) {
    const Params& P = *F.P; unsigned char* ws = F.ws;
    const float* gvec = (which ? P.in[21] : P.in[6]) + l * 1024;
    const float* mod = (const float*)(ws + WS_MOD) + (size_t)l * 17 * 6144;
    const float* xin = (l == 0 && !which) ? P.in[0] : P.out;
    const float* cin = (l == 0 && !which) ? P.in[2] : (const float*)(ws + WS_CTXS);
    bf16_t* H = (bf16_t*)(ws + WS_H);
    for (int r = blockIdx.x * 8 + F.wave; r < T; r += gridDim.x * 8) {
        const int bl = r / SEQT, p = r % SEQT, b = g * GB + bl;
        const float* src; int mrow;
        if (p < CTXL) { if (which && l == 1) continue; src = cin + ((size_t)b * CTXL + p) * DM; mrow = 16; }
        else { src = xin + ((size_t)b * SEQ + p - CTXL) * DM; mrow = b; }
        const float* sh = mod + mrow * 6144 + (which ? 3 : 0) * 1024; const float* sc = sh + 1024;
        f32x4 v[4]; float s = 0.f;
#pragma unroll
        for (int j = 0; j < 4; ++j) { v[j] = ((const GAS f32x4*)src)[F.lane + 64 * j]; s += v[j][0] * v[j][0] + v[j][1] * v[j][1] + v[j][2] * v[j][2] + v[j][3] * v[j][3]; }
        if (l == 0 && !which && p < CTXL) {
            float* cs = (float*)(ws + WS_CTXS) + ((size_t)b * CTXL + p) * DM;
#pragma unroll
            for (int j = 0; j < 4; ++j) ((GAS f32x4*)cs)[F.lane + 64 * j] = v[j]; }
        if (l == 0 && which && p < CTXL) {
            const float* pb = (const float*)(ws + WS_ZG) + ((size_t)bl * CTXL + p) * DM; const float* m2 = mod + 16 * 6144 + 2 * 1024; float* cs = (float*)(ws + WS_CTXS) + ((size_t)b * CTXL + p) * DM;
            s = 0.f;
#pragma unroll
            for (int j = 0; j < 4; ++j) { const int c = (F.lane + 64 * j) * 4; f32x4 a = *(const GAS f32x4*)(pb + c);
#pragma unroll
                for (int k2 = 1; k2 < 4; ++k2) a += *(const GAS f32x4*)(pb + (size_t)k2 * (GB * CTXL) * DM + c);
                v[j] += *(const GAS f32x4*)(m2 + c) * a; *(GAS f32x4*)(cs + c) = v[j];
                s += v[j][0] * v[j][0] + v[j][1] * v[j][1] + v[j][2] * v[j][2] + v[j][3] * v[j][3]; } }
        const float rstd = rsqrtf(wave_sum(s, F.lane) * (1.0f / DM) + EPS);
#pragma unroll
        for (int j = 0; j < 4; ++j) { const int c = (F.lane + 64 * j) * 4;
            const f32x4 gv = *(const GAS f32x4*)(gvec + c), sv = *(const GAS f32x4*)(sc + c), hv = *(const GAS f32x4*)(sh + c);
            const f32x4 y = v[j] * rstd * gv * (sv + 1.0f) + hv;
            u32x2 w; w.x = pk2(y[0], y[1]); w.y = pk2(y[2], y[3]);
            *(GAS u32x2*)(H + (size_t)r * DM + c) = w; }
    }
}

__device__ __forceinline__ void phase_ctxsum(const Ctx& F, int g) {
    unsigned char* ws = F.ws;
    const float* m5 = (const float*)(ws + WS_MOD) + 16 * 6144 + 5 * 1024;
    for (int r = blockIdx.x * 8 + F.wave; r < GB * CTXL; r += gridDim.x * 8) {
        const float* pb = (const float*)(ws + WS_Z1) + (size_t)r * DM; float* cs = (float*)(ws + WS_CTXS) + ((size_t)g * GB * CTXL + r) * DM;
#pragma unroll
        for (int j = 0; j < 4; ++j) { const int c = (F.lane + 64 * j) * 4; f32x4 a = *(const GAS f32x4*)(pb + c);
#pragma unroll
            for (int k2 = 1; k2 < 8; ++k2) a += *(const GAS f32x4*)(pb + (size_t)k2 * (GB * CTXL) * DM + c);
            *(GAS f32x4*)(cs + c) = *(const GAS f32x4*)(cs + c) + *(const GAS f32x4*)(m5 + c) * a; }
    }
}

__device__ __forceinline__ void phase_final(const Ctx& F) {
    const Params& P = *F.P;
    const float* gvec = P.in[26];
    for (int r = blockIdx.x * 8 + F.wave; r < NB * SEQ; r += gridDim.x * 8) {
        float* row = P.out + (size_t)r * DM;
        f32x4 v[4]; float s = 0.f;
#pragma unroll
        for (int j = 0; j < 4; ++j) { v[j] = ((const GAS f32x4*)row)[F.lane + 64 * j]; s += v[j][0] * v[j][0] + v[j][1] * v[j][1] + v[j][2] * v[j][2] + v[j][3] * v[j][3]; }
        const float rstd = rsqrtf(wave_sum(s, F.lane) * (1.0f / DM) + EPS);
#pragma unroll
        for (int j = 0; j < 4; ++j) { const int c = (F.lane + 64 * j) * 4; const f32x4 gv = *(const GAS f32x4*)(gvec + c);
            ((GAS f32x4*)row)[F.lane + 64 * j] = v[j] * rstd * gv; }
    }
}

__device__ __forceinline__ void phase_rowstats(const Ctx& F, int l) {
    const Params& P = *F.P; unsigned char* ws = F.ws;
    bf16_t* QC = (bf16_t*)(ws + WS_H);
    const float* cwt = P.in[8] + (size_t)l * 3 * 1024; const float* cbs = P.in[9] + (size_t)l * 1024;
    const bf16_t* Z1 = (const bf16_t*)(ws + WS_Z1); float* RS = (float*)(ws + WS_RS); bf16_t* KR = (bf16_t*)(ws + WS_KR);
    const float* rope = (const float*)(ws + WS_ROPE);
    for (int r = blockIdx.x * 8 + F.wave; r < T; r += gridDim.x * 8) {
        const bf16_t* zr = Z1 + (size_t)r * NZ1;
        float sq = 0.f, sk = 0.f;
#pragma unroll
        for (int j = 0; j < 3; ++j) { const unsigned w = *(const GAS unsigned*)(zr + ZCQ + j * 128 + 2 * F.lane); const float a = bflo(w), b = bfhi(w); sq += a * a + b * b; }
#pragma unroll
        for (int j = 0; j < 2; ++j) { const unsigned w = *(const GAS unsigned*)(zr + ZCKV + j * 128 + 2 * F.lane); const float a = bflo(w), b = bfhi(w); sk += a * a + b * b; }
        sq = wave_sum(sq, F.lane); sk = wave_sum(sk, F.lane);
        if (F.lane == 0) { RS[r * 2] = rsqrtf(sq * (1.0f / 384.0f) + EPS); RS[r * 2 + 1] = rsqrtf(sk * (1.0f / 256.0f) + EPS); }
        if (F.lane < 32) { const unsigned w = *(const GAS unsigned*)(zr + ZKR + 2 * F.lane); float x1 = bflo(w), x2 = bfhi(w);
            const int p = r % SEQT;
            if (p >= CTXL) { const f32x2 cs = ((const GAS f32x2*)rope)[(size_t)(p - CTXL) * 32 + F.lane]; const float a = x1 * cs.x - x2 * cs.y, b = x1 * cs.y + x2 * cs.x; x1 = a; x2 = b; }
            *(GAS unsigned*)(KR + (size_t)r * 64 + 2 * F.lane) = pk2(x1, x2); }
        {
            const int p = r % SEQT; const bool hp = (p != 0) && (p != CTXL), hn = (p != CTXL - 1) && (p != SEQT - 1);
            const u32x4 z4 = (u32x4){0u, 0u, 0u, 0u};
#pragma unroll
            for (int which = 0; which < 2; ++which) { const int col = which * 512 + F.lane * 8;
                const u32x4 xp = hp ? *(const GAS u32x4*)(zr - NZ1 + col) : z4, xc = *(const GAS u32x4*)(zr + col), xn = hn ? *(const GAS u32x4*)(zr + NZ1 + col) : z4;
                const float osc = which ? 0.08838834764831845f : 1.0f;
                float y[8];
#pragma unroll
                for (int e = 0; e < 8; ++e) { const unsigned wp = e < 2 ? xp.x : e < 4 ? xp.y : e < 6 ? xp.z : xp.w, wc_ = e < 2 ? xc.x : e < 4 ? xc.y : e < 6 ? xc.z : xc.w, wn = e < 2 ? xn.x : e < 4 ? xn.y : e < 6 ? xn.z : xn.w;
                    const float a = cbs[col + e] + cwt[col + e] * ((e & 1) ? bfhi(wp) : bflo(wp)) + cwt[1024 + col + e] * ((e & 1) ? bfhi(wc_) : bflo(wc_)) + cwt[2048 + col + e] * ((e & 1) ? bfhi(wn) : bflo(wn));
                    y[e] = siluf_(a) * osc; }
                u32x4 wv; wv.x = pk2(y[0], y[1]); wv.y = pk2(y[2], y[3]); wv.z = pk2(y[4], y[5]); wv.w = pk2(y[6], y[7]);
                *(GAS u32x4*)(QC + (size_t)r * 1024 + col) = wv; }
        }
    }
}

__device__ __forceinline__ void phase_mout(const Ctx& F, int l) {
    const Params& P = *F.P; unsigned char* ws = F.ws;
    const bf16_t* Z1 = (const bf16_t*)(ws + WS_Z1); const bf16_t* HF = (const bf16_t*)(ws + WS_HF); const bf16_t* HB = (const bf16_t*)(ws + WS_HB);
    bf16_t* Y = (bf16_t*)(ws + WS_Y); const float* gh = P.in[11] + l * 512;
    for (int r = blockIdx.x * 8 + F.wave; r < T; r += gridDim.x * 8) {
        if (l == 1 && (r % SEQT) < CTXL) continue;
        const int c = 8 * F.lane;
        const u32x4 a = *(const GAS u32x4*)(HF + (size_t)r * 512 + c), b = *(const GAS u32x4*)(HB + (size_t)r * 512 + c), o = *(const GAS u32x4*)(Z1 + (size_t)r * NZ1 + ZO + c);
        float h[8];
        h[0] = bflo(a.x) + bflo(b.x); h[1] = bfhi(a.x) + bfhi(b.x); h[2] = bflo(a.y) + bflo(b.y); h[3] = bfhi(a.y) + bfhi(b.y);
        h[4] = bflo(a.z) + bflo(b.z); h[5] = bfhi(a.z) + bfhi(b.z); h[6] = bflo(a.w) + bflo(b.w); h[7] = bfhi(a.w) + bfhi(b.w);
        float s = 0.f;
#pragma unroll
        for (int i = 0; i < 8; ++i) s += h[i] * h[i];
        s += shx(s, 1, F.lane); s += shx(s, 2, F.lane); s += shx(s, 4, F.lane); s += shx(s, 8, F.lane);
        const float rstd = rsqrtf(s * (1.0f / 128.0f) + EPS);
        float og[8];
        og[0] = bflo(o.x); og[1] = bfhi(o.x); og[2] = bflo(o.y); og[3] = bfhi(o.y); og[4] = bflo(o.z); og[5] = bfhi(o.z); og[6] = bflo(o.w); og[7] = bfhi(o.w);
        const f32x4 g0 = *(const GAS f32x4*)(gh + c), g1 = *(const GAS f32x4*)(gh + c + 4);
        float y[8];
#pragma unroll
        for (int i = 0; i < 8; ++i) y[i] = sigmoidf_(og[i]) * (h[i] * rstd * (i < 4 ? g0[i & 3] : g1[i & 3]));
        u32x4 w; w.x = pk2(y[0], y[1]); w.y = pk2(y[2], y[3]); w.z = pk2(y[4], y[5]); w.w = pk2(y[6], y[7]);
        *(GAS u32x4*)(Y + (size_t)r * 1536 + c) = w;
    }
}

__device__ __forceinline__ void phase_ffedge(const Ctx& F, int l) {
    const Params& P = *F.P; unsigned char* ws = F.ws;
    const bf16_t* EDGE = (const bf16_t*)(ws + WS_EDGE); bf16_t* Hd = (bf16_t*)(ws + WS_HID);
    const float* wc = P.in[23] + (size_t)l * 3 * 5632; const float* bc = P.in[24] + (size_t)l * 5632;
    const int ntask = 72 * 4 * 2 * 704;
    for (int q = blockIdx.x * NTHREADS + F.tid; q < ntask; q += gridDim.x * NTHREADS) {
        const int cg4 = q % 704, e = q / 704; const int bot = e & 1, blk = (e >> 1) & 3, tile = e >> 3; const int c = cg4 * 4;
        const int j9 = tile % 9;
        if (l == 1 && j9 == 0) continue;
        const bf16_t* eb = EDGE + ((size_t)(tile * 4 + blk) * 4) * 5632;
        const bf16_t *rp, *rc, *rn; bool hp = true, hn = true;
        if (!bot) { rc = eb; rn = eb + 5632;
            if (blk > 0) rp = eb - 5632;
            else { hp = !(j9 == 0 || j9 == 1); rp = eb - 5632; }
        } else { rc = eb + 3 * 5632; rp = eb + 2 * 5632;
            if (blk < 3) rn = eb + 4 * 5632;
            else { hn = !(j9 == 0 || j9 == 8); rn = eb + 4 * 5632; }
        }
        const u32x2 z2 = (u32x2){0u, 0u};
        const u32x2 gp = hp ? *(const GAS u32x2*)(rp + c) : z2, gc = *(const GAS u32x2*)(rc + c), gn = hn ? *(const GAS u32x2*)(rn + c) : z2;
        const u32x2 vp = hp ? *(const GAS u32x2*)(rp + DFF + c) : z2, vc = *(const GAS u32x2*)(rc + DFF + c), vn = hn ? *(const GAS u32x2*)(rn + DFF + c) : z2;
        const f32x4 wg0 = *(const GAS f32x4*)(wc + c), wg1 = *(const GAS f32x4*)(wc + 5632 + c), wg2 = *(const GAS f32x4*)(wc + 2 * 5632 + c), bg = *(const GAS f32x4*)(bc + c);
        const f32x4 wv0 = *(const GAS f32x4*)(wc + DFF + c), wv1 = *(const GAS f32x4*)(wc + 5632 + DFF + c), wv2 = *(const GAS f32x4*)(wc + 2 * 5632 + DFF + c), bv = *(const GAS f32x4*)(bc + DFF + c);
        float o[4];
#pragma unroll
        for (int j = 0; j < 4; ++j) {
            const unsigned a0 = j < 2 ? gp.x : gp.y, a1 = j < 2 ? gc.x : gc.y, a2 = j < 2 ? gn.x : gn.y, b0 = j < 2 ? vp.x : vp.y, b1 = j < 2 ? vc.x : vc.y, b2 = j < 2 ? vn.x : vn.y;
            const float cgv = bg[j] + wg0[j] * ((j & 1) ? bfhi(a0) : bflo(a0)) + wg1[j] * ((j & 1) ? bfhi(a1) : bflo(a1)) + wg2[j] * ((j & 1) ? bfhi(a2) : bflo(a2));
            const float cvv = bv[j] + wv0[j] * ((j & 1) ? bfhi(b0) : bflo(b0)) + wv1[j] * ((j & 1) ? bfhi(b1) : bflo(b1)) + wv2[j] * ((j & 1) ? bfhi(b2) : bflo(b2));
            o[j] = siluf_(cgv) * cvv;
        }
        u32x2 w; w.x = pk2(o[0], o[1]); w.y = pk2(o[2], o[3]);
        *(GAS u32x2*)(Hd + (size_t)(tile * 256 + blk * 64 + (bot ? 63 : 0)) * DFF + c) = w;
    }
}

constexpr int LP = 136;
__device__ __forceinline__ void sgu_unit(const Ctx& F_, int l, int bl, int c, int gi) {
    Ctx F = F_; { int t_ = F_.lane; asm volatile("" : "+v"(t_)); int w_ = F_.wave; asm volatile("" : "+s"(w_)); F.lane = t_; F.wave = w_; F.tid = w_ * 64 + t_; }
    const Params& P = *F.P; unsigned char* ws = F.ws;
    const bf16_t* Z1 = (const bf16_t*)(ws + WS_Z1); bf16_t* Y = (bf16_t*)(ws + WS_Y);
    LAS bf16_t* Ws = (LAS bf16_t*)F.lds; LAS bf16_t* VnT = Ws + 128 * LP;
    const int R0 = bl * SEQT + c * 128;
    const int t = F.tid, s = t >> 2, cb = (t & 3) * 32;
    {
        const float* wsrc = P.in[17] + (((size_t)l * 4 + gi) * 128 + s) * 128 + cb;
#pragma unroll
        for (int i = 0; i < 4; ++i) { const f32x4 a = *(const GAS f32x4*)(wsrc + i * 8), b = *(const GAS f32x4*)(wsrc + i * 8 + 4);
            u32x4 w; w.x = pk2(a[0], a[1]); w.y = pk2(a[2], a[3]); w.z = pk2(b[0], b[1]); w.w = pk2(b[2], b[3]);
            *(LAS u32x4*)(Ws + s * LP + cb + i * 8) = w; }
        const bf16_t* vsrc = Z1 + (size_t)(R0 + s) * NZ1 + ZS + gi * 128 + cb;
        float v[32]; float sq = 0.f;
#pragma unroll
        for (int i = 0; i < 4; ++i) { const u32x4 w = *(const GAS u32x4*)(vsrc + i * 8);
            v[i * 8 + 0] = geluf_(bflo(w.x)); v[i * 8 + 1] = geluf_(bfhi(w.x)); v[i * 8 + 2] = geluf_(bflo(w.y)); v[i * 8 + 3] = geluf_(bfhi(w.y));
            v[i * 8 + 4] = geluf_(bflo(w.z)); v[i * 8 + 5] = geluf_(bfhi(w.z)); v[i * 8 + 6] = geluf_(bflo(w.w)); v[i * 8 + 7] = geluf_(bfhi(w.w)); }
#pragma unroll
        for (int i = 0; i < 32; ++i) sq += v[i] * v[i];
        sq += shx(sq, 1, F.lane); sq += shx(sq, 2, F.lane);
        const float rstd = rsqrtf(sq * (1.0f / 128.0f) + EPS);
        const float* gs = P.in[16] + l * 512 + gi * 128 + cb;
#pragma unroll
        for (int i = 0; i < 32; ++i) VnT[(cb + i) * LP + s] = f2bf(v[i] * rstd * gs[i]);
    }
    __syncthreads();
    const int fr = F.lane & 15, fq = F.lane >> 4, w = F.wave;
    f32x4 acc[8];
#pragma unroll
    for (int ct = 0; ct < 8; ++ct) acc[ct] = (f32x4){0.f, 0.f, 0.f, 0.f};
#pragma unroll
    for (int kk = 0; kk < 4; ++kk) {
        const bf16x8 bfr = *(const LAS bf16x8*)(Ws + (w * 16 + fr) * LP + kk * 32 + fq * 8);
#pragma unroll
        for (int ct = 0; ct < 8; ++ct) { const bf16x8 afr = *(const LAS bf16x8*)(VnT + (ct * 16 + fr) * LP + kk * 32 + fq * 8); acc[ct] = mfma16(afr, bfr, acc[ct]); }
    }
    const int tt = w * 16 + fr; const float bsv = P.in[18][((size_t)l * 4 + gi) * 128 + tt];
    const bf16_t* usrc = Z1 + (size_t)(R0 + tt) * NZ1 + ZU + gi * 128; bf16_t* yd = Y + (size_t)(R0 + tt) * 1536 + 1024 + gi * 128;
#pragma unroll
    for (int ct = 0; ct < 8; ++ct) { const int ch = ct * 16 + fq * 4; const u32x2 uw = *(const GAS u32x2*)(usrc + ch);
        const float o0 = geluf_(bflo(uw.x)) * (acc[ct][0] + bsv), o1 = geluf_(bfhi(uw.x)) * (acc[ct][1] + bsv), o2 = geluf_(bflo(uw.y)) * (acc[ct][2] + bsv), o3 = geluf_(bfhi(uw.y)) * (acc[ct][3] + bsv);
        u32x2 ow; ow.x = pk2(o0, o1); ow.y = pk2(o2, o3); *(GAS u32x2*)(yd + ch) = ow; }
}

constexpr int KP = 208, VP = 80;
constexpr int ATT_BUF = (64 * KP + 128 * VP) * 2;
constexpr int ANT = 2;
__device__ __forceinline__ void attn_unit(const Ctx& F_, int bl, int h, int qrow0, int nkt) {
    Ctx F = F_; { int t_ = F_.lane; asm volatile("" : "+v"(t_)); int w_ = F_.wave; asm volatile("" : "+s"(w_)); F.lane = t_; F.wave = w_; F.tid = w_ * 64 + t_; }
    unsigned char* ws = F.ws;
    const bf16_t* QA = (const bf16_t*)(ws + WS_QA);
    const char* KNb = (const char*)(ws + WS_KV) + ((size_t)bl * SEQT * 512 + h * 128) * 2;
    const char* KRb = (const char*)(ws + WS_KR) + (size_t)bl * SEQT * 64 * 2;
    const char* VTb = (const char*)(ws + WS_KV) + ((size_t)T * 512 + (size_t)((bl * 4 + h) * 128) * SEQT) * 2;
    bf16_t* Y = (bf16_t*)(ws + WS_Y);
    const int t = F.tid, fr = F.lane & 15, fq = F.lane >> 4, w = F.wave;
    unsigned kofs[4]; int ksel[4]; unsigned vofs[3];
#pragma unroll
    for (int i = 0; i < 4; ++i) { const int q = i * 512 + t; const int row = q / 26, pc = q % 26; const int pcc = pc >= 24 ? 0 : pc;
        ksel[i] = pcc >= 16; kofs[i] = pcc >= 16 ? (unsigned)(row * 64 + (pcc - 16) * 8) * 2u : (unsigned)(row * 512 + pcc * 8) * 2u; }
#pragma unroll
    for (int i = 0; i < 3; ++i) { const int q = i * 512 + t; const int row = q / 10, pc = q % 10; vofs[i] = (unsigned)(row * SEQT + (pc >= 8 ? 0 : pc) * 8) * 2u; }
#define ATT_DMA(kt, bufi) do { LAS unsigned char* kb_ = F.lds + (bufi) * ATT_BUF; const char* kn_ = KNb + (size_t)(kt) * 64 * 512 * 2; const char* kr_ = KRb + (size_t)(kt) * 64 * 64 * 2; const char* vt_ = VTb + (size_t)(kt) * 64 * 2; \
        _Pragma("unroll") for (int i_ = 0; i_ < 4; ++i_) { if (i_ < 3 || t < 128) __builtin_amdgcn_global_load_lds((const GAS unsigned*)((ksel[i_] ? kr_ : kn_) + kofs[i_]), (LAS unsigned*)(kb_ + (i_ * 512 + w * 64) * 16), 16, 0, 0); } \
        _Pragma("unroll") for (int i_ = 0; i_ < 3; ++i_) { if (i_ < 2 || t < 256) __builtin_amdgcn_global_load_lds((const GAS unsigned*)(vt_ + vofs[i_]), (LAS unsigned*)(kb_ + 64 * KP * 2 + (i_ * 512 + w * 64) * 16), 16, 0, 0); } } while (0)
    ATT_DMA(0, 0);
    bf16x8 qf[ANT][6];
#pragma unroll
    for (int tt = 0; tt < ANT; ++tt)
#pragma unroll
        for (int kk = 0; kk < 6; ++kk) qf[tt][kk] = *(const GAS bf16x8*)(QA + (size_t)(qrow0 + w * (16 * ANT) + tt * 16 + fr) * 768 + h * 192 + kk * 32 + fq * 8);
    f32x4 o[8][ANT];
#pragma unroll
    for (int et = 0; et < 8; ++et)
#pragma unroll
        for (int tt = 0; tt < ANT; ++tt) o[et][tt] = (f32x4){0.f, 0.f, 0.f, 0.f};
    float mrun[ANT], lrun[ANT];
#pragma unroll
    for (int tt = 0; tt < ANT; ++tt) { mrun[tt] = -1e30f; lrun[tt] = 0.f; }
    asm volatile("s_waitcnt vmcnt(0)" ::: "memory");
    __syncthreads();
    for (int kt = 0; kt < nkt; ++kt) {
        if (kt + 1 < nkt) ATT_DMA(kt + 1, (kt + 1) & 1);
        const LAS bf16_t* Ks = (const LAS bf16_t*)(F.lds + (kt & 1) * ATT_BUF); const LAS bf16_t* Vt = Ks + 64 * KP;
        f32x4 s[4][ANT];
#pragma unroll
        for (int st = 0; st < 4; ++st)
#pragma unroll
            for (int tt = 0; tt < ANT; ++tt) s[st][tt] = (f32x4){0.f, 0.f, 0.f, 0.f};
        bf16x8 kf[2][4];
#pragma unroll
        for (int st = 0; st < 4; ++st) kf[0][st] = *(const LAS bf16x8*)(Ks + (st * 16 + fr) * KP + fq * 8);
#pragma unroll
        for (int kk = 0; kk < 6; ++kk) {
            if (kk < 5) {
#pragma unroll
                for (int st = 0; st < 4; ++st) kf[(kk + 1) & 1][st] = *(const LAS bf16x8*)(Ks + (st * 16 + fr) * KP + (kk + 1) * 32 + fq * 8);
            }
            __builtin_amdgcn_sched_barrier(0);
#pragma unroll
            for (int st = 0; st < 4; ++st)
#pragma unroll
                for (int tt = 0; tt < ANT; ++tt) s[st][tt] = mfma16(kf[kk & 1][st], qf[tt][kk], s[st][tt]);
            __builtin_amdgcn_sched_barrier(0);
        }
        bf16x8 vf[2][4];
#pragma unroll
        for (int e4 = 0; e4 < 4; ++e4) vf[0][e4] = *(const LAS bf16x8*)(Vt + (e4 * 16 + fr) * VP + fq * 8);
        bf16x8 pf[ANT][2];
        float mx[ANT];
#pragma unroll
        for (int tt = 0; tt < ANT; ++tt) { float m_ = -1e30f;
#pragma unroll
            for (int st = 0; st < 4; ++st) m_ = fmaxf(m_, fmaxf(fmaxf(s[st][tt][0], s[st][tt][1]), fmaxf(s[st][tt][2], s[st][tt][3])));
            mx[tt] = m_; }
#pragma unroll
        for (int tt = 0; tt < ANT; ++tt) mx[tt] = fmaxf(mx[tt], shx(mx[tt], 16, F.lane));
#pragma unroll
        for (int tt = 0; tt < ANT; ++tt) mx[tt] = fmaxf(mx[tt], shx(mx[tt], 32, F.lane));
#pragma unroll
        for (int tt = 0; tt < ANT; ++tt) {
            const bool need = mx[tt] > mrun[tt] + 8.0f;
            if (__builtin_amdgcn_ballot_w64(need) != 0ull) {
                const float mn = need ? mx[tt] : mrun[tt], alpha = __builtin_amdgcn_exp2f(mrun[tt] - mn);
                mrun[tt] = mn; lrun[tt] *= alpha;
#pragma unroll
                for (int et = 0; et < 8; ++et) o[et][tt] *= alpha;
            }
            const float mref = mrun[tt];
            float ps = 0.f;
#pragma unroll
            for (int st = 0; st < 4; ++st)
#pragma unroll
                for (int j = 0; j < 4; ++j) { const float p = __builtin_amdgcn_exp2f(s[st][tt][j] - mref); s[st][tt][j] = p; ps += p; }
            lrun[tt] += ps;
#pragma unroll
            for (int kk = 0; kk < 2; ++kk) { u32x4 pw; pw.x = pk2(s[2 * kk][tt][0], s[2 * kk][tt][1]); pw.y = pk2(s[2 * kk][tt][2], s[2 * kk][tt][3]);
                pw.z = pk2(s[2 * kk + 1][tt][0], s[2 * kk + 1][tt][1]); pw.w = pk2(s[2 * kk + 1][tt][2], s[2 * kk + 1][tt][3]);
                pf[tt][kk] = __builtin_bit_cast(bf16x8, pw); }
        }
#pragma unroll
        for (int gi = 0; gi < 4; ++gi) {
            const int kk = gi >> 1, eb = (gi & 1) * 4;
            if (gi < 3) { const int kk2 = (gi + 1) >> 1, eb2 = ((gi + 1) & 1) * 4;
#pragma unroll
                for (int e4 = 0; e4 < 4; ++e4) vf[(gi + 1) & 1][e4] = *(const LAS bf16x8*)(Vt + ((eb2 + e4) * 16 + fr) * VP + kk2 * 32 + fq * 8);
            }
            __builtin_amdgcn_sched_barrier(0);
#pragma unroll
            for (int e4 = 0; e4 < 4; ++e4)
#pragma unroll
                for (int tt = 0; tt < ANT; ++tt) o[eb + e4][tt] = mfma16(vf[gi & 1][e4], pf[tt][kk], o[eb + e4][tt]);
            __builtin_amdgcn_sched_barrier(0);
        }
        asm volatile("s_waitcnt vmcnt(0)" ::: "memory");
        __syncthreads();
    }
#undef ATT_DMA
#pragma unroll
    for (int tt = 0; tt < ANT; ++tt) {
        float lt = lrun[tt]; lt += shx(lt, 16, F.lane); lt += shx(lt, 32, F.lane);
        const float inv = 1.0f / lt;
        bf16_t* yd = Y + (size_t)(qrow0 + w * (16 * ANT) + tt * 16 + fr) * 1536 + 512 + h * 128;
#pragma unroll
        for (int et = 0; et < 8; ++et) { u32x2 ow; ow.x = pk2(o[et][tt][0] * inv, o[et][tt][1] * inv); ow.y = pk2(o[et][tt][2] * inv, o[et][tt][3] * inv);
            *(GAS u32x2*)(yd + et * 16 + fq * 4) = ow; }
    }
}

__device__ __forceinline__ void mlstm_chain(const Ctx& F_, int l, int bl, int h, int dir) {
    Ctx F = F_; { int t_ = F_.lane; asm volatile("" : "+v"(t_)); int w_ = F_.wave; asm volatile("" : "+s"(w_)); F.lane = t_; F.wave = w_; F.tid = w_ * 64 + t_; }
    const Params& P = *F.P; unsigned char* ws = F.ws;
    const bf16_t* Z1 = (const bf16_t*)(ws + WS_Z1);
    bf16_t* HO = (bf16_t*)(ws + (dir ? WS_HB : WS_HF));
    LAS bf16_t* Qs = (LAS bf16_t*)F.lds; LAS bf16_t* Ks = Qs + 128 * LP; LAS bf16_t* VTs = Ks + 128 * LP; LAS bf16_t* CTs = VTs + 144 * LP;
    LAS float* fb = (LAS float*)(CTs + 144 * LP);
    LAS float* gI = fb, *gF = fb + 128, *sA = fb + 256, *sM = fb + 384, *sB = fb + 512, *sW = fb + 640, *cw = fb + 768;
    const int t = F.tid, fr = F.lane & 15, fq = F.lane >> 4, w = F.wave;
    for (int i = t; i < 1024; i += NTHREADS) { const int which = i >> 9, j = (i >> 7) & 3, c = i & 127; const int col = which * 512 + h * 128 + c;
        cw[i] = j < 3 ? P.in[8][((size_t)l * 3 + j) * 1024 + col] : P.in[9][(size_t)l * 1024 + col]; }
    for (int i = t; i < 16 * LP; i += NTHREADS) VTs[128 * LP + i] = (i < LP) ? (bf16_t)0x3F80 : (bf16_t)0;
    for (int i = t; i < 144 * LP; i += NTHREADS) CTs[i] = 0;
    const float bgi = P.in[10][l * 16 + dir * 8 + h], bgf = P.in[10][l * 16 + dir * 8 + 4 + h];
    f32x4 cta[9];
#pragma unroll
    for (int et = 0; et < 9; ++et) cta[et] = (f32x4){0.f, 0.f, 0.f, 0.f};
    float mstate = 0.f;
    const int tau_s = t >> 2, cb = (t & 3) * 32;
    u32x4 rq[4], rk[4], rv[4];
#define ML_CHUNK(step) (dir == 0 ? (step) : ((step) < 2 ? 1 - (step) : 19 - (step)))
#define ML_LOAD(step) do { const int R0_ = bl * SEQT + ML_CHUNK(step) * 128; const int r_ = dir ? R0_ + 127 - tau_s : R0_ + tau_s; \
        const bf16_t* qb_ = (const bf16_t*)(ws + WS_H) + (size_t)r_ * 1024 + h * 128 + cb; const bf16_t* vb_ = Z1 + (size_t)r_ * NZ1 + ZV + h * 128 + cb; \
        _Pragma("unroll") for (int i_ = 0; i_ < 4; ++i_) { rq[i_] = *(const GAS u32x4*)(qb_ + i_ * 8); rk[i_] = *(const GAS u32x4*)(qb_ + 512 + i_ * 8); rv[i_] = *(const GAS u32x4*)(vb_ + i_ * 8); } } while (0)
    ML_LOAD(0);
    for (int step = 0; step < 18; ++step) {
        const int c = dir == 0 ? step : (step < 2 ? 1 - step : 19 - step);
        const int R0 = bl * SEQT + c * 128;
        const int seq_lo = c < 2 ? bl * SEQT : bl * SEQT + CTXL, seq_hi = c < 2 ? bl * SEQT + CTXL : (bl + 1) * SEQT;
        __syncthreads();
        if (step > 0) {
#pragma unroll
            for (int et = 0; et < 9; ++et)
#pragma unroll
                for (int j = 0; j < 4; ++j) CTs[(et * 16 + fq * 4 + j) * LP + w * 16 + fr] = f2bf(cta[et][j]);
        }
        {
            const int r = dir ? R0 + 127 - tau_s : R0 + tau_s;
            const bool hp = (r - 1) >= seq_lo, hn = (r + 1) < seq_hi;
            const u32x4 z4 = (u32x4){0u, 0u, 0u, 0u};
#pragma unroll
            for (int i = 0; i < 4; ++i) { *(LAS u32x4*)(Qs + tau_s * LP + cb + i * 8) = rq[i]; *(LAS u32x4*)(Ks + tau_s * LP + cb + i * 8) = rk[i]; }
            (void)hp; (void)hn; (void)z4;
#pragma unroll
            for (int i = 0; i < 4; ++i) { const u32x4 xv = rv[i]; LAS bf16_t* vp = VTs + (cb + i * 8) * LP + (tau_s ^ ((t & 3) << 4));
                vp[0 * LP] = (bf16_t)(xv.x & 0xffff); vp[1 * LP] = (bf16_t)(xv.x >> 16); vp[2 * LP] = (bf16_t)(xv.y & 0xffff); vp[3 * LP] = (bf16_t)(xv.y >> 16);
                vp[4 * LP] = (bf16_t)(xv.z & 0xffff); vp[5 * LP] = (bf16_t)(xv.z >> 16); vp[6 * LP] = (bf16_t)(xv.w & 0xffff); vp[7 * LP] = (bf16_t)(xv.w >> 16); }
            if (t < 128) { const int rg = dir ? R0 + 127 - t : R0 + t; const GAS bf16_t* gp = (const GAS bf16_t*)(Z1 + (size_t)rg * NZ1 + ZMG + dir * 8 + h);
                gI[t] = bf2f(gp[0]) + bgi; gF[t] = logsigmoidf_(bf2f(gp[4]) + bgf); }
        }
        __syncthreads();
        if (step + 1 < 18) ML_LOAD(step + 1);
        float M127, wcdec, mnew;
        {
            const float f0 = gF[2 * F.lane], f1 = gF[2 * F.lane + 1];
            const float ps = f0 + f1; float inc = ps;
#pragma unroll
            for (int o2 = 1; o2 < 64; o2 <<= 1) { const float u = shi(inc, F.lane - o2); if (F.lane >= o2) inc += u; }
            const float b0 = inc - ps + f0, b1 = inc;
            const float a0 = gI[2 * F.lane] - b0, a1 = gI[2 * F.lane + 1] - b1;
            float cmi = fmaxf(a0, a1);
#pragma unroll
            for (int o2 = 1; o2 < 64; o2 <<= 1) { const float u = shi(cmi, F.lane - o2); if (F.lane >= o2) cmi = fmaxf(cmi, u); }
            float cme = shi(cmi, F.lane - 1); if (F.lane == 0) cme = -1e30f;
            const float M0 = fmaxf(mstate, fmaxf(cme, a0)), M1 = fmaxf(mstate, cmi);
            M127 = shi(M1, 63); const float blast = shi(b1, 63);
            sA[2 * F.lane] = a0; sA[2 * F.lane + 1] = a1; sM[2 * F.lane] = M0; sM[2 * F.lane + 1] = M1; sB[2 * F.lane] = b0; sB[2 * F.lane + 1] = b1;
            sW[2 * F.lane] = __expf(a0 - M127); sW[2 * F.lane + 1] = __expf(a1 - M127);
            wcdec = __expf(mstate - M127); mnew = blast + M127;
        }
        asm volatile("s_waitcnt lgkmcnt(0)" ::: "memory");
        const int tau = w * 16 + fr;
        const float Mt = sM[tau];
        bf16x8 qf[4];
#pragma unroll
        for (int kk = 0; kk < 4; ++kk) qf[kk] = *(const LAS bf16x8*)(Qs + tau * LP + kk * 32 + fq * 8);
        bf16x8 pf[4];
#pragma unroll
        for (int kk = 0; kk < 4; ++kk) {
            u32x4 pw = (u32x4){0u, 0u, 0u, 0u};
#pragma unroll
            for (int hh = 0; hh < 2; ++hh) { const int st = 2 * kk + hh;
                if (st <= w) {
                    f32x4 sacc = (f32x4){0.f, 0.f, 0.f, 0.f};
#pragma unroll
                    for (int k2 = 0; k2 < 4; ++k2) { const bf16x8 kf = *(const LAS bf16x8*)(Ks + (st * 16 + fr) * LP + k2 * 32 + fq * 8); sacc = mfma16(kf, qf[k2], sacc); }
                    const f32x4 av = *(const LAS f32x4*)(sA + st * 16 + fq * 4);
                    float p[4];
#pragma unroll
                    for (int j = 0; j < 4; ++j) { const int sg = st * 16 + fq * 4 + j; p[j] = sg <= tau ? sacc[j] * __expf(av[j] - Mt) : 0.f; }
                    if (hh == 0) { pw.x = pk2(p[0], p[1]); pw.y = pk2(p[2], p[3]); } else { pw.z = pk2(p[0], p[1]); pw.w = pk2(p[2], p[3]); }
                }
            }
            pf[kk] = __builtin_bit_cast(bf16x8, pw);
        }
        f32x4 nt[9];
#pragma unroll
        for (int et = 0; et < 9; ++et) nt[et] = (f32x4){0.f, 0.f, 0.f, 0.f};
#pragma unroll
        for (int kk = 0; kk < 4; ++kk)
#pragma unroll
            for (int et = 0; et < 9; ++et) { const bf16x8 cf = *(const LAS bf16x8*)(CTs + (et * 16 + fr) * LP + kk * 32 + fq * 8); nt[et] = mfma16(cf, qf[kk], nt[et]); }
        const float winter = __expf(mstate - Mt);
#pragma unroll
        for (int et = 0; et < 9; ++et) nt[et] *= winter;
#pragma unroll
        for (int kk = 0; kk < 4; ++kk) {
            if (2 * kk <= w) {
#pragma unroll
                for (int et = 0; et < 9; ++et) { const int e = et * 16 + fr; const int swz = ((e >> 5) & 3) << 4; const LAS bf16_t* vrow = VTs + e * LP;
                    const u32x2 a0 = *(const LAS u32x2*)(vrow + ((kk * 32 + fq * 4) ^ swz)), a1 = *(const LAS u32x2*)(vrow + ((kk * 32 + 16 + fq * 4) ^ swz));
                    u32x4 aw; aw.x = a0.x; aw.y = a0.y; aw.z = a1.x; aw.w = a1.y;
                    nt[et] = mfma16(__builtin_bit_cast(bf16x8, aw), pf[kk], nt[et]); }
            }
        }
        {
            const float den = shi(nt[8][0], fr);
            const float mt = sB[tau] + Mt;
            const float dn = fmaxf(fabsf(den), __expf(-mt));
            const float inv = 1.0f / dn;
            const int rr = dir ? R0 + 127 - tau : R0 + tau;
            bf16_t* hd = HO + (size_t)rr * 512 + h * 128;
#pragma unroll
            for (int et = 0; et < 8; ++et) { u32x2 ow; ow.x = pk2(nt[et][0] * inv, nt[et][1] * inv); ow.y = pk2(nt[et][2] * inv, nt[et][3] * inv); *(GAS u32x2*)(hd + et * 16 + fq * 4) = ow; }
        }
#pragma unroll
        for (int et = 0; et < 9; ++et) cta[et] *= wcdec;
#pragma unroll
        for (int kk = 0; kk < 4; ++kk) {
            const int s0 = kk * 32 + fq * 8;
            const f32x4 w0 = *(const LAS f32x4*)(sW + s0), w1 = *(const LAS f32x4*)(sW + s0 + 4);
            const LAS bf16_t* kcol = Ks + s0 * LP + w * 16 + fr;
            u32x4 bw;
            bw.x = pk2(bf2f(kcol[0 * LP]) * w0[0], bf2f(kcol[1 * LP]) * w0[1]); bw.y = pk2(bf2f(kcol[2 * LP]) * w0[2], bf2f(kcol[3 * LP]) * w0[3]);
            bw.z = pk2(bf2f(kcol[4 * LP]) * w1[0], bf2f(kcol[5 * LP]) * w1[1]); bw.w = pk2(bf2f(kcol[6 * LP]) * w1[2], bf2f(kcol[7 * LP]) * w1[3]);
            const bf16x8 bfr = __builtin_bit_cast(bf16x8, bw);
#pragma unroll
            for (int et = 0; et < 9; ++et) { const int e = et * 16 + fr; const int swz = ((e >> 5) & 3) << 4;
                const bf16x8 af = *(const LAS bf16x8*)(VTs + e * LP + (s0 ^ swz)); cta[et] = mfma16(af, bfr, cta[et]); }
        }
        mstate = mnew;
    }
}

__device__ __forceinline__ void phase_mixers(const Ctx& F, int l, int g, int rep) {
    unsigned* counter = (unsigned*)(F.ws + WS_CNT) + (l * 2 + g) * 4 + rep;
    LAS unsigned* slot = (LAS unsigned*)(F.lds + LDS_BYTES - 16);
    constexpr int QB = 2048 / (128 * ANT), CB = 256 / (128 * ANT);
    const int NL = GB * 4 * QB, NA = NL + (l == 0 ? GB * 4 * CB : 0), nch = (l == 0 ? 18 : 16), NS = GB * nch * 4;
    const int total = 64 + NA + NS;
    for (;;) {
        __syncthreads();
        if (F.tid == 0) *slot = __hip_atomic_fetch_add(counter, 1u, __ATOMIC_RELAXED, __HIP_MEMORY_SCOPE_AGENT);
        __syncthreads();
        int it = (int)*slot;
        if (it >= total) break;
        if (it < 64) { REP(7) { __syncthreads(); mlstm_chain(F, l, it >> 3, (it >> 1) & 3, it & 1); } continue; }
        it -= 64;
        if (it < NA) {
            if (it < NL) { const int bl = it / (4 * QB), h = (it / QB) & 3, qb = it % QB; REP(8) { __syncthreads(); attn_unit(F, bl, h, bl * SEQT + CTXL + qb * (128 * ANT), 36); } }
            else { const int ci = it - NL; const int bl = ci / (4 * CB), h = (ci / CB) & 3, cbk = ci % CB; attn_unit(F, bl, h, bl * SEQT + cbk * (128 * ANT), 4); }
            continue;
        }
        it -= NA;
        { const int bl = it / (nch * 4), rem = it % (nch * 4); sgu_unit(F, l, bl, (rem >> 2) + (l == 0 ? 0 : 2), rem & 3); }
    }
}

__global__ void __launch_bounds__(NTHREADS) fwd_megakernel(Params P) {
    extern __shared__ __attribute__((aligned(16))) unsigned char lds_raw[];
    cg::grid_group grid = cg::this_grid();
    Ctx F; F.lds = (LAS unsigned char*)lds_raw; F.wave = __builtin_amdgcn_readfirstlane(threadIdx.x >> 6); F.lane = 0; F.tid = 0; F.P = &P; F.ws = P.ws;
    const int wave0 = F.wave;
    const int G = gridDim.x, c = blockIdx.x;
    volatile LAS unsigned* bst = (volatile LAS unsigned*)(F.lds + LDS_BYTES - 32);
    { int t0_; asm volatile("v_mbcnt_lo_u32_b32 %0, -1, 0\n\tv_mbcnt_hi_u32_b32 %0, -1, %0" : "=v"(t0_));
      if (wave0 == 0 && t0_ < 2) bst[t0_] = 0u;
      __syncthreads();
      if (wave0 == 0 && t0_ == 0) (void)xb_add((unsigned*)(P.ws + WS_BAR) + XB_XCNT(xb_xcc_id()), 1u); }
#define GSYNC() do { REP(3) { int tb_; asm volatile("v_mbcnt_lo_u32_b32 %0, -1, 0\n\tv_mbcnt_hi_u32_b32 %0, -1, %0" : "=v"(tb_)); \
        xcd_barrier((unsigned*)(P.ws + WS_BAR), bst, wave0 == 0 && tb_ == 0); } } while (0)
#define REFRESH() int l = l_; int g = g_; unsigned char* ws = P.ws; do { int t_; asm volatile("v_mbcnt_lo_u32_b32 %0, -1, 0\n\tv_mbcnt_hi_u32_b32 %0, -1, %0" : "=v"(t_)); int w_ = wave0; asm volatile("" : "+s"(w_)); F.lane = t_; F.wave = w_; F.tid = w_ * 64 + t_; \
        asm volatile("" : "+s"(l)); asm volatile("" : "+s"(g)); asm volatile("" : "+s"(ws)); F.ws = ws; } while (0)
#define REFRESH_TID() do { int t_; asm volatile("v_mbcnt_lo_u32_b32 %0, -1, 0\n\tv_mbcnt_hi_u32_b32 %0, -1, %0" : "=v"(t_)); int w_ = wave0; asm volatile("" : "+s"(w_)); F.lane = t_; F.wave = w_; F.tid = w_ * 64 + t_; asm volatile("" : "+s"(l)); asm volatile("" : "+s"(g)); } while (0)
#pragma nounroll
    for (int l_ = 0; l_ < 2; ++l_) {
        REP(4) { const int g_ = 0; REFRESH(); (void)g; phase_prep(F, l); }
        if (l_ == 0) grid.sync();
        { const int g_ = 0; REFRESH(); phase_norm(F, l, g, 0); }
        GSYNC();
#pragma nounroll
        for (int g_ = 0; g_ < NGRP; ++g_) {
            if (l_ == 0) { REFRESH(); (void)l; (void)g; pg8::Order S; S.init(72, NIN, G, c, 0); pg8::Gemm gm{(const bf16_t*)(ws + WS_H), (const bf16_t*)(ws + WS_WIN), 1024, NIN, 1024, 1024};
              EpiIn E{(bf16_t*)(ws + WS_Z1), (bf16_t*)(ws + WS_ZG)}; pg8::gemm_phase(F.lds, gm, S, E, F.tid); }
            else { REFRESH(); (void)l; (void)g; pg8::OrderL1In S; S.base.init(64, NIN, G, c, 1); pg8::Gemm gm{(const bf16_t*)(ws + WS_H), (const bf16_t*)(ws + WS_WIN), 1024, NIN, 1024, 1024};
              EpiIn E{(bf16_t*)(ws + WS_Z1), (bf16_t*)(ws + WS_ZG)}; pg8::gemm_phase(F.lds, gm, S, E, F.tid); }
            GSYNC();
            REP(2) { REFRESH(); (void)g; phase_rowstats(F, l); }
            GSYNC();
            REP(6) {
            { REFRESH(); (void)l; (void)g; pg8::Order S; S.init(72, 768, G, c, 0); pg8::Gemm gm{(const bf16_t*)(ws + WS_Z1) + ZCQ, (const bf16_t*)(ws + WS_WUQ), NZ1, 768, 384, 384};
              EpiQ E{(bf16_t*)(ws + WS_QA), (const float*)(ws + WS_RS), (const float*)(ws + WS_ROPE)}; pg8::gemm_phase(F.lds, gm, S, E, F.tid); }
            { REFRESH(); (void)l; (void)g; pg8::Order S; S.init(72, 512, G, (c + G - (216 % G)) % G, 0);     pg8::Gemm gm{(const bf16_t*)(ws + WS_Z1) + ZCKV, (const bf16_t*)(ws + WS_WUKV), NZ1, 512, 256, 256};
              EpiBf E{(bf16_t*)(ws + WS_KV), 512, (const float*)(ws + WS_RS) + 1}; pg8::gemm_phase(F.lds, gm, S, E, F.tid); }
            { REFRESH(); (void)l; (void)g; pg8::Order S; S.init(2, T, G, (c + G - (104 % G)) % G, 0); pg8::Gemm gm{(const bf16_t*)(ws + WS_WUKV) + (size_t)512 * 256, (const bf16_t*)(ws + WS_Z1) + ZCKV, 256, T, 256, NZ1};
              EpiVT E{(bf16_t*)(ws + WS_KV) + (size_t)T * 512, (const float*)(ws + WS_RS) + 1}; pg8::gemm_phase(F.lds, gm, S, E, F.tid); }
            }
            GSYNC();
            REP(0) { REFRESH(); phase_mixers(F, l, g, rep_); }
            GSYNC();
            REP(2) { REFRESH(); (void)g; phase_mout(F, l); }
            GSYNC();
            REP(5) { REFRESH(); (void)g; const int skip = (l == 1), nM = skip ? 64 : 72; pg8::Order S; S.init(nM, 1024, G, c, skip);
              pg8::Gemm gm{(const bf16_t*)(ws + WS_Y), (const bf16_t*)(ws + WS_WBR), 1536, 1024, 1536, 1536};
              EpiMerge E{(const bf16_t*)(ws + WS_ZG), (bf16_t*)(ws + WS_MB)}; pg8::gemm_phase(F.lds, gm, S, E, F.tid); }
            GSYNC();
            { REFRESH(); pg8::Order S; S.init(64, 1024, G, c, 1);
              pg8::Gemm gm{(const bf16_t*)(ws + WS_MB), (const bf16_t*)(ws + WS_WOUT), 1024, 1024, 1024, 1024};
              EpiRes E{l == 0 ? P.in[0] : P.out, P.out, l == 0 ? P.in[2] : (const float*)(ws + WS_CTXS), (float*)(ws + WS_CTXS), (const float*)(ws + WS_MOD) + (size_t)l * 17 * 6144, 2, g};
              pg8::gemm_phase(F.lds, gm, S, E, F.tid); }
            if (l_ == 0) for (int tk = c; tk < 128; tk += G) { REFRESH(); (void)l;
              const int un = tk >> 2, ks = tk & 3; pg8::OneUnit S{(un >> 2) * 9, un & 3, 1};
              pg8::Gemm gm{(const bf16_t*)(ws + WS_MB) + ks * 256, (const bf16_t*)(ws + WS_WOUT) + ks * 256, 1024, 1024, 256, 1024};
              EpiCtxPart E{(float*)(ws + WS_ZG), ks}; pg8::gemm_phase(F.lds, gm, S, E, F.tid); }
            GSYNC();
            REP(2) { REFRESH(); phase_norm(F, l, g, 1); }
            GSYNC();
            { REFRESH(); (void)g; const int skip = (l == 1); pg8::Order S; S.init(skip ? 64 : 72, 5632, G, c, skip);
              pg8::Gemm gm{(const bf16_t*)(ws + WS_H), (const bf16_t*)(ws + WS_WUP), 1024, 5632, 1024, 1024};
              EpiUpConv E{(bf16_t*)(ws + WS_HID), (bf16_t*)(ws + WS_EDGE), P.in[23] + (size_t)l * 3 * 5632, P.in[24] + (size_t)l * 5632}; pg8::gemm_phase(F.lds, gm, S, E, F.tid); }
            GSYNC();
            REP(2) { REFRESH(); (void)g; phase_ffedge(F, l); }
            GSYNC();
            { REFRESH(); pg8::Order S; S.init(64, 1024, G, c, 1);
              pg8::Gemm gm{(const bf16_t*)(ws + WS_HID), (const bf16_t*)(ws + WS_WDN), DFF, 1024, DFF, DFF};
              EpiRes E{P.out, P.out, (const float*)(ws + WS_CTXS), (float*)(ws + WS_CTXS), (const float*)(ws + WS_MOD) + (size_t)l * 17 * 6144, 5, g};
              pg8::gemm_phase(F.lds, gm, S, E, F.tid); }
            if (l_ == 0) for (int tk = c; tk < 256; tk += G) { REFRESH(); (void)l;
              const int un = tk >> 3, ks = tk & 7; const int k0 = ks < 6 ? ks * 384 : 2304 + (ks - 6) * 256, kl = ks < 6 ? 384 : 256;
              pg8::OneUnit S{(un >> 2) * 9, un & 3, 1};
              pg8::Gemm gm{(const bf16_t*)(ws + WS_HID) + k0, (const bf16_t*)(ws + WS_WDN) + k0, DFF, 1024, kl, DFF};
              EpiCtxPart E{(float*)(ws + WS_Z1), ks}; pg8::gemm_phase(F.lds, gm, S, E, F.tid); }
            if (g_ == 0) { const int gsave = 1; { int l = l_; int g = gsave; unsigned char* ws = P.ws; (void)ws; REFRESH_TID(); phase_norm(F, l, g, 0); } }
            GSYNC();
            if (l_ == 0) { { REFRESH(); (void)l; phase_ctxsum(F, g); } GSYNC(); }
        }
    }
    { const int l_ = 0, g_ = 0; REFRESH(); (void)l; (void)g; (void)ws; phase_final(F); }
}

extern "C" void kernel_launch(void* const* d_in, const int* in_sizes, int n_in, void* d_out, int out_size, void* d_ws, size_t ws_size, hipStream_t stream) {
    static int grid_blocks = 0;
    if (!grid_blocks) {
        int dev = 0, cus = 0, per_cu = 0;
        hipGetDevice(&dev);
        hipDeviceGetAttribute(&cus, hipDeviceAttributeMultiprocessorCount, dev);
        hipFuncSetAttribute((const void*)fwd_megakernel, hipFuncAttributeMaxDynamicSharedMemorySize, LDS_BYTES);
        hipOccupancyMaxActiveBlocksPerMultiprocessor(&per_cu, (const void*)fwd_megakernel, NTHREADS, LDS_BYTES);
        if (per_cu < 1) per_cu = 1;
        grid_blocks = cus * 1;
        if (ws_size < WS_END) fprintf(stderr, "kernel_launch: workspace too small: %zu < %zu\n", ws_size, (size_t)WS_END);
    }
    Params p{};
    for (int i = 0; i < 27; ++i) p.in[i] = (const float*)d_in[i];
    p.out = (float*)d_out; p.ws = (unsigned char*)d_ws;
    (void)hipMemsetAsync((unsigned char*)d_ws + WS_CNT, 0, 4096 + 16384, stream);
    void* args[] = {&p};
    hipError_t e = hipLaunchCooperativeKernel((const void*)fwd_megakernel, dim3(grid_blocks), dim3(NTHREADS), args, LDS_BYTES, stream);
    if (e != hipSuccess) fprintf(stderr, "cooperative launch failed: %s (grid %d)\n", hipGetErrorString(e), grid_blocks);
}
```
